# Optimizing an MI355X kernel written in HIP

```python
import jax, jax.numpy as jnp
from jax import lax
import numpy as np

D_MODEL = 1024
BATCH = 8
SEQ = 4096
DEPTH = 2

CTX_LEN = 256
GRID_W = 64
N_BRANCH = 3
GLA_WIDTH = D_MODEL
GLA_HEADS = 4
GLA_HV = GLA_WIDTH // GLA_HEADS
GLA_HK = GLA_HV // 2
GLA_RANK = 16
GLA_TAU = 16.0
HGRN_WIDTH = D_MODEL
HGRN_HEADS = D_MODEL // 128
HGRN_HV = HGRN_WIDTH // HGRN_HEADS
HGRN_EXPAND = 128
HGRN_F = HGRN_HEADS * HGRN_EXPAND
ATT_HD = 128
ATT_HQ = D_MODEL // ATT_HD
ATT_HKV = ATT_HQ // 4
ATT_WIDTH = ATT_HQ * ATT_HD
WINDOW = 128
ATT_BLOCK = 128
ROPE_BASE = 10000.0
CHUNK = 16
EPS = 1e-6
IN_SIZES = (GLA_HEADS * GLA_HK, GLA_HEADS * GLA_HK, GLA_WIDTH, GLA_WIDTH, 2 * GLA_RANK,
            HGRN_F, 2 * HGRN_F, HGRN_WIDTH, HGRN_WIDTH,
            ATT_WIDTH, ATT_HKV * ATT_HD, ATT_HKV * ATT_HD, ATT_WIDTH,
            N_BRANCH * D_MODEL)
N_IN = sum(IN_SIZES)

kernel_name = 'hybrid_gla_hgrn2_swa_prefix_dit_block'


def _rms_norm(x, g):
    xf = x.astype(jnp.float32)
    y = xf * lax.rsqrt(jnp.mean(xf * xf, axis=-1, keepdims=True) + EPS)
    return (y * g.astype(jnp.float32)).astype(x.dtype)


def _modulation(cond, w_ada, b_ada):
    m = jnp.matmul(jax.nn.silu(cond), w_ada) + b_ada
    return tuple(t[:, None, :] for t in jnp.split(m, 3, axis=-1))


def _split_in(p):
    return jnp.split(p, np.cumsum(IN_SIZES)[:-1].tolist(), axis=-1)


def _to_heads(t, n_heads):
    bsz, t_len, w = t.shape
    return t.reshape(bsz, t_len, n_heads, w // n_heads).transpose(0, 2, 1, 3)


def _flip(t):
    return jnp.flip(t, axis=2)


def _chunked_recurrence(q, k, v, log_a, s0):
    f32 = jnp.float32
    bsz, nh, t_len, _ = q.shape
    dv = v.shape[-1]
    n = t_len // CHUNK

    def blk(t):
        return t.astype(f32).reshape(bsz, nh, n, CHUNK, t.shape[-1])

    q, k, v, log_a = blk(q), blk(k), blk(v), blk(log_a)
    b = jnp.cumsum(log_a, axis=3)
    b_end = b[:, :, :, -1:, :]
    q_dec = q * jnp.exp(b)
    att = jnp.einsum('bhnik,bhnjk->bhnij', q_dec, k * jnp.exp(-b))
    att = jnp.where(jnp.tril(jnp.ones((CHUNK, CHUNK), dtype=bool)), att, 0.0)
    o_intra = jnp.einsum('bhnij,bhnjv->bhniv', att, v)
    k_end = k * jnp.exp(b_end - b)
    decay = jnp.exp(b_end[:, :, :, 0, :])

    def step(state, inp):
        qd, ke, vc, dc = inp
        o = jnp.einsum('bhik,bhkv->bhiv', qd, state)
        state = dc[..., None] * state + jnp.einsum('bhjk,bhjv->bhkv', ke, vc)
        return state, o

    xs = tuple(jnp.moveaxis(t, 2, 0) for t in (q_dec, k_end, v, decay))
    s_final, o_inter = lax.scan(step, s0, xs)
    o = o_intra + jnp.moveaxis(o_inter, 0, 2)
    return o.reshape(bsz, nh, t_len, dv), s_final


def _bidir_recurrence(lat, ctx):
    qc, kcf, kcb, vc, lcf, lcb = ctx
    q, kf, kb, v, lgf, lgb = lat
    s0 = jnp.zeros(qc.shape[:2] + (qc.shape[-1], vc.shape[-1]), jnp.float32)
    oc_f, s_f = _chunked_recurrence(qc, kcf, vc, lcf, s0)
    oc_b, s_b = _chunked_recurrence(_flip(qc), _flip(kcb), _flip(vc), _flip(lcb), s0)
    o_f, _ = _chunked_recurrence(q, kf, v, lgf, s_f)
    o_b, _ = _chunked_recurrence(_flip(q), _flip(kb), _flip(v), _flip(lgb), s_b)
    return o_f + _flip(o_b), oc_f + _flip(oc_b)


def _gla_streams(q, k, v, lr, w_a2, b_a2):
    q = _to_heads(q, GLA_HEADS) * (GLA_HK ** -0.5)
    k = _to_heads(k, GLA_HEADS)
    v = _to_heads(v, GLA_HEADS)
    bsz, t_len, _ = lr.shape
    lr = lr.reshape(bsz, t_len, 2, GLA_RANK)
    z = jnp.einsum('btdr,drk->dbtk', lr, w_a2) + b_a2[:, None, None, :]
    log_a = jax.nn.log_sigmoid(z.astype(jnp.float32)) / GLA_TAU
    return (q, k, k, v, _to_heads(log_a[0], GLA_HEADS), _to_heads(log_a[1], GLA_HEADS))


def _hgrn_streams(q, f, i, lb):
    bsz, t_len, _ = f.shape
    z = f.reshape(bsz, t_len, 2, HGRN_F).astype(jnp.float32)
    log_f = jnp.logaddexp(jnp.log(lb), jnp.log1p(-lb) + jax.nn.log_sigmoid(z))
    k = -jnp.expm1(log_f)
    h = HGRN_HEADS
    return (_to_heads(q, h), _to_heads(k[:, :, 0], h), _to_heads(k[:, :, 1], h), _to_heads(i, h),
            _to_heads(log_f[:, :, 0], h), _to_heads(log_f[:, :, 1], h))


def _head_norm_gate(o, gain, gate):
    bsz, nh, t_len, dv = o.shape
    o = _rms_norm(jnp.transpose(o, (0, 2, 1, 3)), gain).reshape(bsz, t_len, nh * dv)
    return o.astype(gate.dtype) * jax.nn.silu(gate)


def _rope_1d(u, pos):
    r = u.shape[-1] // 2
    inv = ROPE_BASE ** (-jnp.arange(r, dtype=jnp.float32) / r)
    ang = pos.astype(jnp.float32)[:, None] * inv
    cos, sin = jnp.cos(ang)[:, None, :], jnp.sin(ang)[:, None, :]
    uf = u.astype(jnp.float32)
    u1, u2 = uf[..., :r], uf[..., r:]
    return jnp.concatenate([u1 * cos - u2 * sin, u2 * cos + u1 * sin], axis=-1).astype(u.dtype)


def _axial_rope(t, row, col):
    half = t.shape[-1] // 2
    return jnp.concatenate([_rope_1d(t[..., :half], row), _rope_1d(t[..., half:], col)], axis=-1)


def _window_attention(q, k, v, kc, vc, sink):
    f32 = jnp.float32
    bsz, s_len, _, hd = q.shape
    nb = s_len // ATT_BLOCK
    grp = ATT_HQ // ATT_HKV
    qb = (q * hd ** -0.5).reshape(bsz, nb, ATT_BLOCK, ATT_HKV, grp, hd)

    def band(t):
        tp = jnp.pad(t, ((0, 0), (ATT_BLOCK, ATT_BLOCK), (0, 0), (0, 0)))
        tp = tp.reshape(bsz, nb + 2, ATT_BLOCK, ATT_HKV, hd)
        return jnp.concatenate([tp[:, :-2], tp[:, 1:-1], tp[:, 2:]], axis=2)

    kw, vw = band(k), band(v)
    qi = jnp.arange(ATT_BLOCK)
    kj = jnp.arange(3 * ATT_BLOCK)
    blk = jnp.arange(nb)
    rel = kj[None, :] - ATT_BLOCK - qi[:, None]
    kpos = blk[:, None] * ATT_BLOCK - ATT_BLOCK + kj[None, :]
    mask = (jnp.abs(rel) <= WINDOW)[None] & ((kpos >= 0) & (kpos < s_len))[:, None, :]
    s_loc = jnp.einsum('bnqhgd,bnkhd->bhgnqk', qb, kw).astype(f32)
    s_loc = jnp.where(mask, s_loc, -jnp.inf)
    s_ctx = jnp.einsum('bnqhgd,bchd->bhgnqc', qb, kc).astype(f32)
    sk = jnp.broadcast_to(sink.astype(f32).reshape(1, ATT_HKV, grp, 1, 1, 1), s_ctx.shape[:-1] + (1,))
    p = jax.nn.softmax(jnp.concatenate([sk, s_ctx, s_loc], axis=-1), axis=-1).astype(v.dtype)
    n_ctx = kc.shape[1]
    out = (jnp.einsum('bhgnqc,bchd->bnqhgd', p[..., 1:1 + n_ctx], vc)
           + jnp.einsum('bhgnqk,bnkhd->bnqhgd', p[..., 1 + n_ctx:], vw))
    return out.reshape(bsz, s_len, ATT_HQ * hd)


def _context_attention(qc, kc, vc, sink):
    f32 = jnp.float32
    bsz, n_ctx, _, hd = qc.shape
    grp = ATT_HQ // ATT_HKV
    qs = (qc * hd ** -0.5).reshape(bsz, n_ctx, ATT_HKV, grp, hd)
    s = jnp.einsum('bqhgd,bkhd->bhgqk', qs, kc).astype(f32)
    sk = jnp.broadcast_to(sink.astype(f32).reshape(1, ATT_HKV, grp, 1, 1), s.shape[:-1] + (1,))
    p = jax.nn.softmax(jnp.concatenate([sk, s], axis=-1), axis=-1).astype(vc.dtype)
    out = jnp.einsum('bhgqk,bkhd->bqhgd', p[..., 1:], vc)
    return out.reshape(bsz, n_ctx, ATT_HQ * hd)


def _merge(ys, mg, w_branch, w_out):
    y = jnp.stack(ys, axis=2)
    proj = jnp.einsum('btnw,nwd->btnd', y, w_branch)
    gates = jax.nn.sigmoid(mg.reshape(mg.shape[:-1] + (N_BRANCH, D_MODEL)).astype(jnp.float32))
    merged = jnp.sum(gates.astype(proj.dtype) * proj, axis=2)
    return jnp.matmul(merged, w_out)


def _layer(x, ctx, c, c_ctx, row, col, norm_g, w_ada, b_ada, w_in, gla_w_a2, gla_b_a2, gla_norm_g,
           hgrn_lb, hgrn_norm_g, attn_sink, w_branch, w_out, update_ctx):
    shift, scale, gate = _modulation(c, w_ada, b_ada)
    shift_c, scale_c, gate_c = _modulation(c_ctx[None], w_ada, b_ada)
    h = _rms_norm(x, norm_g) * (1.0 + scale) + shift
    hc = _rms_norm(ctx, norm_g) * (1.0 + scale_c) + shift_c
    (ga_q, ga_k, ga_v, ga_g, ga_lr, hg_q, hg_f, hg_i, hg_g,
     wa_q, wa_k, wa_v, wa_g, mg) = _split_in(jnp.matmul(h, w_in))
    (gac_q, gac_k, gac_v, gac_g, gac_lr, hgc_q, hgc_f, hgc_i, hgc_g,
     wac_q, wac_k, wac_v, wac_g, mgc) = _split_in(jnp.matmul(hc, w_in))

    o_gla, oc_gla = _bidir_recurrence(_gla_streams(ga_q, ga_k, ga_v, ga_lr, gla_w_a2, gla_b_a2),
                                      _gla_streams(gac_q, gac_k, gac_v, gac_lr, gla_w_a2, gla_b_a2))
    y_gla = _head_norm_gate(o_gla, gla_norm_g, ga_g)

    o_hg, oc_hg = _bidir_recurrence(_hgrn_streams(hg_q, hg_f, hg_i, hgrn_lb),
                                    _hgrn_streams(hgc_q, hgc_f, hgc_i, hgrn_lb))
    y_hg = _head_norm_gate(o_hg, hgrn_norm_g, hg_g)

    bsz, s_len, _ = x.shape
    n_ctx = ctx.shape[1]
    q = _axial_rope(wa_q.reshape(bsz, s_len, ATT_HQ, ATT_HD), row, col)
    k = _axial_rope(wa_k.reshape(bsz, s_len, ATT_HKV, ATT_HD), row, col)
    v = wa_v.reshape(bsz, s_len, ATT_HKV, ATT_HD)
    kc = wac_k.reshape(bsz, n_ctx, ATT_HKV, ATT_HD)
    vc = wac_v.reshape(bsz, n_ctx, ATT_HKV, ATT_HD)
    y_att = _window_attention(q, k, v, kc, vc, attn_sink) * jax.nn.silu(wa_g)

    x_new = x + gate * _merge((y_gla, y_hg, y_att), mg, w_branch, w_out)
    if update_ctx:
        yc_gla = _head_norm_gate(oc_gla, gla_norm_g, gac_g)
        yc_hg = _head_norm_gate(oc_hg, hgrn_norm_g, hgc_g)
        qc = wac_q.reshape(bsz, n_ctx, ATT_HQ, ATT_HD)
        yc_att = _context_attention(qc, kc, vc, attn_sink) * jax.nn.silu(wac_g)
        ctx = ctx + gate_c * _merge((yc_gla, yc_hg, yc_att), mgc, w_branch, w_out)
    return x_new, ctx


def setup_inputs(seed: int = 0) -> dict:
    key = jax.random.key(seed)
    ks = jax.random.split(key, 20)
    f32 = jnp.float32

    def nrm(k, shape, scale):
        return jax.random.normal(k, shape, f32) * scale

    d = D_MODEL
    return {
        'x': nrm(ks[0], (BATCH, SEQ, d), 1.0),
        'c': nrm(ks[1], (BATCH, d), 1.0),
        'ctx': nrm(ks[2], (BATCH, CTX_LEN, d), 1.0),
        'c_ctx': nrm(ks[3], (d,), 1.0),
        'norm_g': 1.0 + nrm(ks[4], (DEPTH, d), 0.1),
        'w_ada': nrm(ks[5], (DEPTH, d, 3 * d), 0.5 * d ** -0.5),
        'b_ada': nrm(ks[6], (DEPTH, 3 * d), 0.02),
        'w_in': nrm(ks[7], (DEPTH, d, N_IN), d ** -0.5),
        'gla_w_a2': nrm(ks[8], (DEPTH, 2, GLA_RANK, GLA_HEADS * GLA_HK), GLA_RANK ** -0.5),
        'gla_b_a2': nrm(ks[9], (DEPTH, 2, GLA_HEADS * GLA_HK), 0.1),
        'gla_norm_g': 1.0 + nrm(ks[10], (DEPTH, GLA_HV), 0.1),
        'hgrn_lb_logits': nrm(ks[11], (DEPTH, 2, HGRN_F), 1.0),
        'hgrn_norm_g': 1.0 + nrm(ks[12], (DEPTH, HGRN_HV), 0.1),
        'attn_sink': nrm(ks[13], (DEPTH, ATT_HQ), 1.0),
        'w_branch': nrm(ks[14], (DEPTH, N_BRANCH, D_MODEL, d), D_MODEL ** -0.5),
        'w_out': nrm(ks[15], (DEPTH, d, d), d ** -0.5),
        'final_g': 1.0 + nrm(ks[16], (d,), 0.1),
    }


def reference(x, c, ctx, c_ctx, norm_g, w_ada, b_ada, w_in, gla_w_a2, gla_b_a2, gla_norm_g,
              hgrn_lb_logits, hgrn_norm_g, attn_sink, w_branch, w_out, final_g):
    s_len = x.shape[1]
    n_rows = s_len // GRID_W
    row = jnp.repeat(jnp.arange(n_rows), GRID_W)
    col = jnp.tile(jnp.arange(GRID_W), n_rows)
    lb_cum = jnp.cumsum(jax.nn.softmax(hgrn_lb_logits.astype(jnp.float32), axis=0), axis=0)
    lower_bounds = lb_cum - lb_cum[0]
    for l in range(DEPTH):
        x, ctx = _layer(x, ctx, c, c_ctx, row, col, norm_g[l], w_ada[l], b_ada[l], w_in[l],
                        gla_w_a2[l], gla_b_a2[l], gla_norm_g[l], lower_bounds[l], hgrn_norm_g[l],
                        attn_sink[l], w_branch[l], w_out[l], l < DEPTH - 1)
    return _rms_norm(x, final_g)
```

```cpp
#include <hip/hip_runtime.h>
#include <hip/hip_cooperative_groups.h>
#include <cstdio>
namespace cg = cooperative_groups;

typedef unsigned short bf16_t;
using bf16x8 = __attribute__((ext_vector_type(8))) short;
using f32x4 = __attribute__((ext_vector_type(4))) float;
using f32x16 = __attribute__((ext_vector_type(16))) float;
#define DI __device__ __forceinline__
#define MFMA16(a, b, c) __builtin_amdgcn_mfma_f32_16x16x32_bf16((a), (b), (c), 0, 0, 0)
#define MFMA32(a, b, c) __builtin_amdgcn_mfma_f32_32x32x16_bf16((a), (b), (c), 0, 0, 0)

typedef __bf16 bf16v2_t __attribute__((ext_vector_type(2)));
typedef float f32v2_t __attribute__((ext_vector_type(2)));
DI unsigned pack2(float a, float b) { f32v2_t v = {a, b}; bf16v2_t r = __builtin_convertvector(v, bf16v2_t); return __builtin_bit_cast(unsigned, r); }
DI bf16_t f2bf(float x) { return (bf16_t)(pack2(x, 0.f) & 0xffffu); }
DI float bf2f(bf16_t h) { return __uint_as_float(((unsigned)h) << 16); }
DI float bflo(unsigned u) { return __uint_as_float(u << 16); }
DI float bfhi(unsigned u) { return __uint_as_float(u & 0xffff0000u); }
DI float sigmoidf_(float z) { return __builtin_amdgcn_rcpf(1.f + __expf(-z)); }
DI float siluf_(float z) { return z * __builtin_amdgcn_rcpf(1.f + __expf(-z)); }
DI float logsigf_(float z) { return fminf(z, 0.f) - __logf(1.f + __expf(-fabsf(z))); }

DI int tid_() { int t = threadIdx.x & 255; asm volatile("" : "+v"(t)); __builtin_assume(t >= 0 && t < 256); return t; }
DI int tid512_() { int t = threadIdx.x; asm volatile("" : "+v"(t)); __builtin_assume(t >= 0 && t < 512); return t; }

constexpr int T = 34816;
constexpr int SP = 4352;
constexpr int NWIN = 14848;
constexpr int NIN = 13856;
constexpr float EPSN = 1e-6f;

constexpr size_t SZ_ACT = (size_t)T * 1024 * 2;
constexpr size_t OFF_WINT = 0;
constexpr size_t OFF_WBRT = OFF_WINT + (size_t)NWIN * 1024 * 2;
constexpr size_t OFF_WOUTT = OFF_WBRT + (size_t)3 * 1024 * 1024 * 2;
constexpr size_t OFF_H = OFF_WOUTT + (size_t)1024 * 1024 * 2;
constexpr size_t OFF_YGLA = OFF_H + SZ_ACT;
constexpr size_t OFF_YHG = OFF_YGLA + SZ_ACT;
constexpr size_t OFF_MODP = OFF_YHG + SZ_ACT;
constexpr size_t OFF_MOD = OFF_MODP + (size_t)8 * 2 * 9 * 3072 * 4;
constexpr size_t OFF_LB = OFF_MOD + (size_t)2 * 9 * 3072 * 4;
constexpr size_t OFF_ROPE = OFF_LB + (size_t)2 * 2 * 1024 * 4;
constexpr size_t OFF_BAR = OFF_ROPE + (size_t)64 * 32 * 2 * 4;
constexpr size_t OFF_CTX1 = OFF_BAR + 16384;
constexpr size_t OFF_R = OFF_CTX1 + (size_t)2048 * 1024 * 4;
constexpr size_t R_TR = 0;
constexpr size_t R_RMG = (size_t)8 * 2048 * SP * 2;
constexpr size_t R_O = R_RMG + (size_t)T * 512 * 2;
constexpr size_t R_ATT_V = (size_t)T * 2304 * 2;
constexpr size_t WS_NEED = OFF_R + R_O + SZ_ACT;

struct Params {
  const float *x, *c, *ctx, *c_ctx, *norm_g, *w_ada, *b_ada, *w_in, *gla_w_a2, *gla_b_a2, *gla_norm_g, *hgrn_lb,
      *hgrn_norm_g, *attn_sink, *w_branch, *w_out, *final_g;
  float* out;
  char* ws;
};

DI void modp_item(const Params& p, int item, char* smem) {
  const int kp = item & 7, jb = (item >> 3) % 12, l = item / 96;
  float(*s)[128] = (float(*)[128])smem;
  const int tid = tid_();
  for (int e = tid; e < 9 * 128; e += 256) {
    int r = e >> 7, k = e & 127;
    float v = (r < 8) ? p.c[r * 1024 + kp * 128 + k] : p.c_ctx[kp * 128 + k];
    s[r][k] = siluf_(v);
  }
  __syncthreads();
  float acc[9];
#pragma unroll
  for (int r = 0; r < 9; ++r) acc[r] = 0.f;
  const float* w = p.w_ada + (size_t)l * 1024 * 3072 + (size_t)(kp * 128) * 3072 + jb * 256 + tid;
#pragma unroll 4
  for (int k = 0; k < 128; ++k) {
    float wv = w[(size_t)k * 3072];
#pragma unroll
    for (int r = 0; r < 9; ++r) acc[r] += s[r][k] * wv;
  }
  float* mp = (float*)(p.ws + OFF_MODP) + ((size_t)(kp * 2 + l) * 9) * 3072 + jb * 256 + tid;
#pragma unroll
  for (int r = 0; r < 9; ++r) mp[(size_t)r * 3072] = acc[r];
  __syncthreads();
}

DI void tables_item(const Params& p) {
  const int tid = tid_();
  float* lb = (float*)(p.ws + OFF_LB);
  for (int e = tid; e < 2048; e += 256) {
    lb[e] = 0.f;
    float a = p.hgrn_lb[e], b = p.hgrn_lb[2048 + e];
    lb[2048 + e] = 1.f / (1.f + expf(a - b));
  }
  float* rt = (float*)(p.ws + OFF_ROPE);
  for (int e = tid; e < 64 * 32; e += 256) {
    int pos = e >> 5, i = e & 31;
    float inv = powf(10000.f, -(float)i / 32.f);
    float ang = (float)pos * inv;
    rt[2 * e] = cosf(ang);
    rt[2 * e + 1] = sinf(ang);
  }
}

DI int win_src_col(int n, int& la_d, int& la_c) {
  if (n < 4096) {
    int hh = n >> 11, j = n & 2047;
    if (j < 256) return hh * 256 + j;
    if (j < 512) return 512 + hh * 256 + (j - 256);
    if (j < 1024) return 1024 + hh * 512 + (j - 512);
    if (j < 1536) return 2048 + hh * 512 + (j - 1024);
    la_d = (j - 1536) >> 8;
    la_c = hh * 256 + ((j - 1536) & 255);
    return -1;
  }
  if (n < 9216) {
    int m = n - 4096;
    int hh = m / 2560, j = m % 2560;
    if (j < 512) return 3104 + hh * 512 + j;
    if (j < 1024) return 4128 + hh * 512 + (j - 512);
    if (j < 1536) return 5152 + hh * 512 + (j - 1024);
    if (j < 2048) return 6176 + hh * 512 + (j - 1536);
    return 7200 + hh * 512 + (j - 2048);
  }
  if (n < 11776) return 8224 + (n - 9216);
  return 10784 + (n - 11776);
}

DI void transpose_tile(const float* src, int ld_src, int k0, int c0, bf16_t* dst, int ld_dst, char* smem) {
  float(*tile)[65] = (float(*)[65])smem;
  const int tid = tid_();
#pragma unroll
  for (int i = 0; i < 4; ++i) {
    int kk = (tid >> 4) + 16 * i, c4 = (tid & 15) * 4;
    float4 v = *(const float4*)(src + (size_t)(k0 + kk) * ld_src + c0 + c4);
    tile[kk][c4] = v.x; tile[kk][c4 + 1] = v.y; tile[kk][c4 + 2] = v.z; tile[kk][c4 + 3] = v.w;
  }
  __syncthreads();
#pragma unroll
  for (int i = 0; i < 2; ++i) {
    int nn = (tid >> 3) + 32 * i, k8 = (tid & 7) * 8;
    uint4 o;
    o.x = pack2(tile[k8][nn], tile[k8 + 1][nn]);
    o.y = pack2(tile[k8 + 2][nn], tile[k8 + 3][nn]);
    o.z = pack2(tile[k8 + 4][nn], tile[k8 + 5][nn]);
    o.w = pack2(tile[k8 + 6][nn], tile[k8 + 7][nn]);
    *(uint4*)(dst + (size_t)nn * ld_dst + k0 + k8) = o;
  }
  __syncthreads();
}

constexpr int NW_ITEMS = 232 * 16 + 768 + 256;
DI void weight_item(const Params& p, int l, int item, char* smem) {
  const int tid = tid_();
  if (item < 232 * 16) {
    const int nt = item >> 4, kt = item & 15;
    const int n0 = nt * 64, k0 = kt * 64;
    int la_d = 0, la_c = 0;
    const int sc = win_src_col(n0, la_d, la_c);
    const float* win = p.w_in + (size_t)l * 1024 * NIN;
    bf16_t* dst = (bf16_t*)(p.ws + OFF_WINT) + (size_t)n0 * 1024;
    if (sc >= 0) {
      transpose_tile(win, NIN, k0, sc, dst, 1024, smem);
    } else {
      const int kk = tid & 63, nq = tid >> 6;
      const float* lrp = win + (size_t)(k0 + kk) * NIN + 3072 + la_d * 16;
      float lr[16];
#pragma unroll
      for (int r4 = 0; r4 < 4; ++r4) {
        float4 v = *(const float4*)(lrp + 4 * r4);
        lr[4 * r4] = v.x; lr[4 * r4 + 1] = v.y; lr[4 * r4 + 2] = v.z; lr[4 * r4 + 3] = v.w;
      }
      const float* a2 = p.gla_w_a2 + ((size_t)(l * 2 + la_d) * 16) * 512 + la_c + nq * 16;
#pragma unroll 1
      for (int nn = 0; nn < 16; ++nn) {
        float sacc = 0.f;
#pragma unroll
        for (int r = 0; r < 16; ++r) sacc += lr[r] * a2[(size_t)r * 512 + nn];
        dst[(size_t)(nq * 16 + nn) * 1024 + k0 + kk] = f2bf(sacc);
      }
    }
  } else if (item < 232 * 16 + 768) {
    int it = item - 232 * 16;
    const int n = it >> 8, dt = (it >> 4) & 15, kt = it & 15;
    const float* src = p.w_branch + ((size_t)(l * 3 + n)) * 1024 * 1024;
    bf16_t* dst = (bf16_t*)(p.ws + OFF_WBRT) + ((size_t)n * 1024 + dt * 64) * 1024;
    transpose_tile(src, 1024, kt * 64, dt * 64, dst, 1024, smem);
  } else {
    int it = item - 232 * 16 - 768;
    const int dt = it >> 4, kt = it & 15;
    const float* src = p.w_out + (size_t)l * 1024 * 1024;
    bf16_t* dst = (bf16_t*)(p.ws + OFF_WOUTT) + (size_t)(dt * 64) * 1024;
    transpose_tile(src, 1024, kt * 64, dt * 64, dst, 1024, smem);
  }
}

DI void h_item(const Params& p, int l, int item) {
  const int tid = tid_(), lane = tid & 63, w = tid >> 6;
  const float* ng = p.norm_g + l * 1024;
  bf16_t* H = (bf16_t*)(p.ws + OFF_H);
  for (int rr = 0; rr < 32; ++rr) {
    const int row = item * 128 + w * 32 + rr;
    const int b = row / SP, pos = row % SP;
    const float* src;
    int mr;
    if (pos < 256) {
      src = (l == 0 ? p.ctx : (const float*)(p.ws + OFF_CTX1)) + (size_t)(b * 256 + pos) * 1024;
      mr = 8;
    } else {
      src = (l == 0 ? p.x : (const float*)p.out) + (size_t)(b * 4096 + pos - 256) * 1024;
      mr = b;
    }
    const float* mod = (const float*)(p.ws + OFF_MOD) + ((size_t)(l * 9 + mr)) * 3072;
    float4 v[4];
    float ss = 0.f;
#pragma unroll
    for (int i = 0; i < 4; ++i) {
      v[i] = *(const float4*)(src + i * 256 + lane * 4);
      ss += v[i].x * v[i].x + v[i].y * v[i].y + v[i].z * v[i].z + v[i].w * v[i].w;
    }
#pragma unroll
    for (int o = 32; o >= 1; o >>= 1) ss += __shfl_xor(ss, o);
    const float rstd = rsqrtf(ss * (1.f / 1024.f) + EPSN);
#pragma unroll
    for (int i = 0; i < 4; ++i) {
      const int c = i * 256 + lane * 4;
      float4 g4 = *(const float4*)(ng + c);
      float4 sh = *(const float4*)(mod + c);
      float4 sc = *(const float4*)(mod + 1024 + c);
      float y0 = v[i].x * rstd * g4.x * (1.f + sc.x) + sh.x;
      float y1 = v[i].y * rstd * g4.y * (1.f + sc.y) + sh.y;
      float y2 = v[i].z * rstd * g4.z * (1.f + sc.z) + sh.z;
      float y3 = v[i].w * rstd * g4.w * (1.f + sc.w) + sh.w;
      *(uint2*)(H + (size_t)row * 1024 + c) = make_uint2(pack2(y0, y1), pack2(y2, y3));
    }
  }
}

typedef unsigned u32x4_t __attribute__((ext_vector_type(4)));
DI void gload16(u32x4_t& r, const void* sbase, unsigned voff) {
  asm volatile("global_load_dwordx4 %0, %1, %2" : "=v"(r) : "v"(voff), "s"(sbase) : "memory");
}
template <int NB>
DI void gemm_wait(u32x4_t (&ra)[4], u32x4_t (&rb)[NB]);
template <>
DI void gemm_wait<4>(u32x4_t (&ra)[4], u32x4_t (&rb)[4]) {
  asm volatile("s_waitcnt vmcnt(8)"
               : "+v"(ra[0]), "+v"(ra[1]), "+v"(ra[2]), "+v"(ra[3]), "+v"(rb[0]), "+v"(rb[1]), "+v"(rb[2]), "+v"(rb[3])
               :
               : "memory");
}
template <>
DI void gemm_wait<2>(u32x4_t (&ra)[4], u32x4_t (&rb)[2]) {
  asm volatile("s_waitcnt vmcnt(6)"
               : "+v"(ra[0]), "+v"(ra[1]), "+v"(ra[2]), "+v"(ra[3]), "+v"(rb[0]), "+v"(rb[1])
               :
               : "memory");
}
template <int NB>
DI void gemm_drain(u32x4_t (&ra)[4], u32x4_t (&rb)[NB]);
template <>
DI void gemm_drain<4>(u32x4_t (&ra)[4], u32x4_t (&rb)[4]) {
  asm volatile("s_waitcnt vmcnt(0)"
               : "+v"(ra[0]), "+v"(ra[1]), "+v"(ra[2]), "+v"(ra[3]), "+v"(rb[0]), "+v"(rb[1]), "+v"(rb[2]), "+v"(rb[3])
               :
               : "memory");
}
template <>
DI void gemm_drain<2>(u32x4_t (&ra)[4], u32x4_t (&rb)[2]) {
  asm volatile("s_waitcnt vmcnt(0)"
               : "+v"(ra[0]), "+v"(ra[1]), "+v"(ra[2]), "+v"(ra[3]), "+v"(rb[0]), "+v"(rb[1])
               :
               : "memory");
}

template <int NT>
DI void gemm512(f32x16 (&acc)[4][NT], const bf16_t* __restrict__ A, const bf16_t* __restrict__ Bt, int m0, int n0,
                char* smem) {
  typedef bf16_t(*tile_t)[256][72];
  tile_t As = (tile_t)smem;
  tile_t Bs = (tile_t)(smem + 73728);
  constexpr int NB = 2 * NT;
  const int tid = tid512_(), lane = tid & 63, w = tid >> 6, wm = w >> 2, wn = w & 3;
  const int l32 = lane & 31, h = lane >> 5;
  const int lr = tid >> 3, lc = (tid & 7) * 8;
  const unsigned voff = (unsigned)(lr * 1024 + lc) * 2u;
  const bf16_t* Ab = A + (size_t)m0 * 1024;
  const bf16_t* Bb = Bt + (size_t)n0 * 1024;
  u32x4_t xa[4], xb[NB];
#define GEMM_ISSUE(RA, RB, KT)                                                                     \
  {                                                                                                \
    const int kn_ = min((KT), 15) * 64;                                                            \
    _Pragma("unroll") for (int i = 0; i < 4; ++i) gload16(RA[i], Ab + (size_t)(64 * i) * 1024 + kn_, voff);  \
    _Pragma("unroll") for (int i = 0; i < NB; ++i) gload16(RB[i], Bb + (size_t)(64 * i) * 1024 + kn_, voff); \
  }
#define GEMM_STORE(RA, RB, BUF)                                                                    \
  {                                                                                                \
    _Pragma("unroll") for (int i = 0; i < 4; ++i) *(u32x4_t*)&As[BUF][lr + 64 * i][lc] = RA[i];   \
    _Pragma("unroll") for (int i = 0; i < NB; ++i) *(u32x4_t*)&Bs[BUF][lr + 64 * i][lc] = RB[i];  \
  }
#define GEMM_COMPUTE(BUF)                                                                                              \
  _Pragma("unroll") for (int ks = 0; ks < 4; ++ks) {                                                                   \
    bf16x8 af[4], bfr[NT];                                                                                             \
    _Pragma("unroll") for (int mt = 0; mt < 4; ++mt) af[mt] =                                                          \
        *(const bf16x8*)&As[BUF][128 * wm + 32 * mt + l32][16 * ks + 8 * h];                                          \
    _Pragma("unroll") for (int nt = 0; nt < NT; ++nt) bfr[nt] =                                                        \
        *(const bf16x8*)&Bs[BUF][32 * NT * wn + 32 * nt + l32][16 * ks + 8 * h];                                      \
    _Pragma("unroll") for (int mt = 0; mt < 4; ++mt) _Pragma("unroll") for (int nt = 0; nt < NT; ++nt) acc[mt][nt] =   \
        MFMA32(af[mt], bfr[nt], acc[mt][nt]);                                                                          \
  }
  GEMM_ISSUE(xa, xb, 0);
  gemm_drain<NB>(xa, xb);
  GEMM_STORE(xa, xb, 0);
  GEMM_ISSUE(xa, xb, 1);
  __syncthreads();
#pragma unroll 1
#define GEMM_FRAGS(BUF, KS, AF, BF)                                                                                    \
  {                                                                                                                    \
    _Pragma("unroll") for (int mt = 0; mt < 4; ++mt) AF[mt] =                                                          \
        *(const bf16x8*)&As[BUF][128 * wm + 32 * mt + l32][16 * (KS) + 8 * h];                                        \
    _Pragma("unroll") for (int nt = 0; nt < NT; ++nt) BF[nt] =                                                         \
        *(const bf16x8*)&Bs[BUF][32 * NT * wn + 32 * nt + l32][16 * (KS) + 8 * h];                                    \
  }
#define GEMM_MFMAS(AF, BF)                                                                                             \
  _Pragma("unroll") for (int mt = 0; mt < 4; ++mt) _Pragma("unroll") for (int nt = 0; nt < NT; ++nt) acc[mt][nt] =     \
      MFMA32(AF[mt], BF[nt], acc[mt][nt]);
#define GEMM_HALF(BUF, OTHER, KNEXT)                                                                                   \
  {                                                                                                                    \
    bf16x8 af0[4], bf0[NT];                                                                                            \
    GEMM_FRAGS(BUF, 0, af0, bf0);                                                                                      \
    bf16x8 af1[4], bf1[NT];                                                                                            \
    GEMM_FRAGS(BUF, 1, af1, bf1);                                                                                      \
    GEMM_MFMAS(af0, bf0);                                                                                              \
    gemm_drain<NB>(xa, xb);                                     \
    GEMM_STORE(xa, xb, OTHER);                                                                                         \
    GEMM_ISSUE(xa, xb, KNEXT);                                                                                         \
    GEMM_FRAGS(BUF, 2, af0, bf0);                                                                                      \
    GEMM_MFMAS(af1, bf1);                                                                                              \
    GEMM_FRAGS(BUF, 3, af1, bf1);                                                                                      \
    GEMM_MFMAS(af0, bf0);                                                                                              \
    GEMM_MFMAS(af1, bf1);                                                                                              \
  }
  for (int kt = 0; kt < 16; kt += 2) {
    GEMM_HALF(0, 1, kt + 2);
    __syncthreads();
    GEMM_HALF(1, 0, kt + 3);
    __syncthreads();
  }
#undef GEMM_FRAGS
#undef GEMM_MFMAS
#undef GEMM_HALF
  gemm_drain<NB>(xa, xb);
#undef GEMM_ISSUE
#undef GEMM_STORE
#undef GEMM_COMPUTE
}

template <int NT>
DI void zero_acc(f32x16 (&acc)[4][NT]) {
#pragma unroll
  for (int mt = 0; mt < 4; ++mt)
#pragma unroll
    for (int nt = 0; nt < NT; ++nt)
#pragma unroll
      for (int i = 0; i < 16; ++i) acc[mt][nt][i] = 0.f;
}

DI void inproj_tile(const Params& p, int l, int u, int mtile, int ntile, char* smem) {
  const int ubase = (u < 2) ? u * 2048 : (u < 4 ? 4096 + (u - 2) * 2560 : 9216);
  f32x16 acc[4][2];
  zero_acc<2>(acc);
  const int m0 = mtile * 256, n0 = ntile * 256;
  gemm512<2>(acc, (const bf16_t*)(p.ws + OFF_H), (const bf16_t*)(p.ws + OFF_WINT) + (size_t)ubase * 1024, m0, n0, smem);
  const int tid = tid512_(), lane = tid & 63, w = tid >> 6, wm = w >> 2, wn = w & 3;
  const int l32 = lane & 31, h = lane >> 5;
  const int b = m0 / SP;
  const int pos_w = (m0 % SP) + 128 * wm;
  const int row_w = m0 + 128 * wm;
  const int jb = n0 + 64 * wn;
  char* R = p.ws + OFF_R;
  bf16_t* stage = (bf16_t*)(smem + w * 18432);
  int kind, off;
  bf16_t* dbase;
  int ld = 0;
  if (u < 2) {
    if (jb < 1024) { kind = 0; off = 0; dbase = (bf16_t*)(R + R_TR) + (size_t)b * 1536 * SP; }
    else if (jb < 1536) { kind = 1; off = -1024; dbase = (bf16_t*)(R + R_RMG); ld = 512; }
    else { kind = 0; off = -512; dbase = (bf16_t*)(R + R_TR) + (size_t)b * 1536 * SP; }
  } else if (u < 4) {
    if (jb < 2048) { kind = 0; off = 0; dbase = (bf16_t*)(R + R_TR) + (size_t)b * 2048 * SP; }
    else { kind = 1; off = -2048; dbase = (bf16_t*)(R + R_RMG); ld = 512; }
  } else {
    if (jb < 1280) { kind = 1; off = 0; dbase = (bf16_t*)R; ld = 2304; }
    else if (jb < 1536) { kind = 0; off = -1280; dbase = (bf16_t*)(R + R_ATT_V) + (size_t)b * 256 * SP; }
    else { kind = 1; off = -256; dbase = (bf16_t*)R; ld = 2304; }
  }
  if (u == 4 && jb < 1280) {
    const float* rt = (const float*)(p.ws + OFF_ROPE);
    const float qs = (jb < 1024) ? 0.08838834764831845f : 1.f;
    const int half = (jb >> 6) & 1;
#pragma unroll
    for (int mt = 0; mt < 4; ++mt)
#pragma unroll
      for (int i = 0; i < 16; ++i) {
        const int rr = 32 * mt + 8 * (i >> 2) + 4 * h + (i & 3);
        const int pos = pos_w + rr;
        const float u1 = acc[mt][0][i], u2 = acc[mt][1][i];
        float o1 = u1, o2 = u2;
        if (pos >= 256) {
          const int t = pos - 256;
          const int pp = half ? (t & 63) : (t >> 6);
          const float2 cs = *(const float2*)(rt + (size_t)(pp * 32 + l32) * 2);
          o1 = u1 * cs.x - u2 * cs.y;
          o2 = u2 * cs.x + u1 * cs.y;
        }
        stage[rr * 72 + l32] = f2bf(o1 * qs);
        stage[rr * 72 + 32 + l32] = f2bf(o2 * qs);
      }
  } else {
#pragma unroll
    for (int nt = 0; nt < 2; ++nt) {
      const int j = jb + 32 * nt + l32;
      int mode = 0;
      float aux = 0.f;
      if (u < 2) {
        if (j < 256) mode = 1;
        else if (j >= 1536) { mode = 3; const int d = (j - 1536) >> 8, cc = (j - 1536) & 255;
                              aux = p.gla_b_a2[(size_t)(l * 2 + d) * 512 + u * 256 + cc]; }
      } else if (u < 4) {
        if (j >= 512 && j < 1536) { mode = 4; const int d = (j - 512) >> 9, cc = (j - 512) & 511;
                                    aux = ((const float*)(p.ws + OFF_LB))[(size_t)(l * 2 + d) * 1024 + (u - 2) * 512 + cc]; }
      }
#pragma unroll
      for (int mt = 0; mt < 4; ++mt)
#pragma unroll
        for (int q = 0; q < 4; ++q) {
          float v[4];
#pragma unroll
          for (int e = 0; e < 4; ++e) v[e] = acc[mt][nt][4 * q + e];
          if (mode == 1) {
#pragma unroll
            for (int e = 0; e < 4; ++e) v[e] *= 0.08838834764831845f;
          } else if (mode == 3) {
#pragma unroll
            for (int e = 0; e < 4; ++e) v[e] = logsigf_(v[e] + aux) * (1.f / 16.f);
          } else if (mode == 4) {
#pragma unroll
            for (int e = 0; e < 4; ++e) v[e] = (aux > 0.f) ? __logf(aux + (1.f - aux) * sigmoidf_(v[e])) : logsigf_(v[e]);
          }
          const int rr = 32 * mt + 8 * q + 4 * h;
          if (kind == 0) {
            *(uint2*)(stage + (32 * nt + l32) * 136 + rr) = make_uint2(pack2(v[0], v[1]), pack2(v[2], v[3]));
          } else {
            const unsigned p01 = pack2(v[0], v[1]), p23 = pack2(v[2], v[3]);
            bf16_t* sp = stage + rr * 72 + 32 * nt + l32;
            sp[0] = (bf16_t)(p01 & 0xffffu); sp[72] = (bf16_t)(p01 >> 16);
            sp[144] = (bf16_t)(p23 & 0xffffu); sp[216] = (bf16_t)(p23 >> 16);
          }
        }
    }
  }
  if (kind == 0) {
    bf16_t* dst = dbase + (size_t)(jb + off + (lane >> 4)) * SP + pos_w + 8 * (lane & 15);
    const bf16_t* src = stage + (lane >> 4) * 136 + 8 * (lane & 15);
#pragma unroll
    for (int i = 0; i < 16; ++i) *(uint4*)(dst + (size_t)(4 * i) * SP) = *(const uint4*)(src + 4 * i * 136);
  } else {
    bf16_t* dst = dbase + (size_t)(row_w + (lane >> 3)) * ld + jb + off + 8 * (lane & 7);
    const bf16_t* src = stage + (lane >> 3) * 72 + 8 * (lane & 7);
#pragma unroll
    for (int i = 0; i < 16; ++i) *(uint4*)(dst + (size_t)(8 * i) * ld) = *(const uint4*)(src + 8 * i * 72);
  }
  __syncthreads();
}

DI bf16x8 ld_perm(const bf16_t* rowp, int g) {
  uint2 a = *(const uint2*)(rowp + 4 * g);
  uint2 b = *(const uint2*)(rowp + 16 + 4 * g);
  uint4 r = make_uint4(a.x, a.y, b.x, b.y);
  return __builtin_bit_cast(bf16x8, r);
}
DI bf16x8 pack_acc2(const f32x4& a, const f32x4& b) {
  uint4 r = make_uint4(pack2(a[0], a[1]), pack2(a[2], a[3]), pack2(b[0], b[1]), pack2(b[2], b[3]));
  return __builtin_bit_cast(bf16x8, r);
}

struct ScanRaw { uint4 la0, la1, q0, q1, k0, k1, v; };

template <bool gla, int dir>
DI void scan_body(const Params& p, int hl, int vs, int b, char* smem) {
  constexpr int V = gla ? 256 : 128, ntr = gla ? 1536 : 2048;
  const int qcol = hl * 128;
  const int kcol = 256 + hl * 128;
  const int lacol = gla ? (1024 + dir * 256 + hl * 128) : (512 + dir * 512 + hl * 128);
  const int vcol = gla ? (512 + hl * 256 + vs * 64) : (1536 + hl * 128 + vs * 64);
  char* R = p.ws + OFF_R;
  const bf16_t* TRb = (const bf16_t*)(R + R_TR) + (size_t)b * ntr * SP;
  bf16_t* O = (bf16_t*)(R + R_O) + (size_t)dir * T * 512;

  constexpr int BUFB = 33280;
  const int tid = tid512_(), lane = tid & 63, w = tid >> 6, l16 = lane & 15, g = lane >> 4;
  const int vt = tid & 255;
  const int c = vt >> 1, th = vt & 1;
  const int pc = (c & ~31) | (8 * ((c & 15) >> 2) + (c & 3) + ((c & 16) ? 4 : 0));
  const int vn = vt >> 2, vpc = vt & 3;
  const bf16_t* la_g = TRb + (size_t)(lacol + c) * SP + 16 * th;
  const bf16_t* q_g = TRb + (size_t)(qcol + c) * SP + 16 * th;
  const bf16_t* k_g = TRb + (size_t)(kcol + c) * SP + 16 * th;
  const bf16_t* v_g = TRb + (size_t)(vcol + vn) * SP + 8 * vpc;
  bf16_t* Og = O + (size_t)(b * SP + 4 * g) * 512 + hl * V + vs * 64 + 16 * (w & 3) + l16;

  auto chunk_pos = [&](int ch) -> int {
    return (dir == 0) ? ch * 32 : (ch < 8 ? (7 - ch) * 32 : 256 + (135 - ch) * 32);
  };
  auto load_raw = [&](ScanRaw& r, int ch) {
    const int p0 = chunk_pos(ch);
    r.la0 = *(const uint4*)(la_g + p0);
    r.la1 = *(const uint4*)(la_g + p0 + 8);
    r.q0 = *(const uint4*)(q_g + p0);
    r.q1 = *(const uint4*)(q_g + p0 + 8);
    if (gla) {
      r.k0 = *(const uint4*)(k_g + p0);
      r.k1 = *(const uint4*)(k_g + p0 + 8);
    }
    r.v = *(const uint4*)(v_g + p0);
  };
  auto prep = [&](const ScanRaw& r, char* buf) {
    bf16_t(*Qd)[136] = (bf16_t(*)[136])buf;
    bf16_t(*Kd)[136] = (bf16_t(*)[136])(buf + 8704);
    bf16_t(*KdT)[40] = (bf16_t(*)[40])(buf + 17408);
    bf16_t(*VT)[40] = (bf16_t(*)[40])(buf + 27648);
    float* dec = (float*)(buf + 32768);
    {
      const int vp0 = 16 * (vpc & 1) + 4 * (vpc >> 1);
      *(uint2*)&VT[vn][vp0] = make_uint2(r.v.x, r.v.y);
      *(uint2*)&VT[vn][vp0 + 8] = make_uint2(r.v.z, r.v.w);
    }
    const unsigned lau[8] = {r.la0.x, r.la0.y, r.la0.z, r.la0.w, r.la1.x, r.la1.y, r.la1.z, r.la1.w};
    const unsigned qu[8] = {r.q0.x, r.q0.y, r.q0.z, r.q0.w, r.q1.x, r.q1.y, r.q1.z, r.q1.w};
    const unsigned ku[8] = {r.k0.x, r.k0.y, r.k0.z, r.k0.w, r.k1.x, r.k1.y, r.k1.z, r.k1.w};
    float f[16], ea[16], eb[16];
#pragma unroll
    for (int i = 0; i < 8; ++i) { f[2 * i] = __expf(bflo(lau[i])); f[2 * i + 1] = __expf(bfhi(lau[i])); }
    float own = 1.f;
    if (dir == 0) {
      float run = 1.f;
#pragma unroll
      for (int i = 0; i < 16; ++i) { run *= f[i]; ea[i] = run; }
      own = run;
      run = 1.f;
#pragma unroll
      for (int i = 15; i >= 0; --i) { eb[i] = run; run *= f[i]; }
    } else {
      float run = 1.f;
#pragma unroll
      for (int i = 15; i >= 0; --i) { run *= f[i]; ea[i] = run; }
      own = run;
      run = 1.f;
#pragma unroll
      for (int i = 0; i < 16; ++i) { eb[i] = run; run *= f[i]; }
    }
    const float other = __shfl_xor(own, 1);
    const float total = own * other;
    const float mula = (dir == 0) ? (th == 1 ? other : 1.f) : (th == 0 ? other : 1.f);
    const float mulb = ((dir == 0) ? (th == 0 ? other : 1.f) : (th == 1 ? other : 1.f)) *
                       __builtin_amdgcn_rcpf(fmaxf(total, 1e-35f));
    if (th == 0) dec[c] = total;
    unsigned kdp[8];
#pragma unroll
    for (int i = 0; i < 8; ++i) {
      float kd2[2], qd2[2];
#pragma unroll
      for (int h2 = 0; h2 < 2; ++h2) {
        const int ii = 2 * i + h2;
        const float qv = (h2 ? bfhi(qu[i]) : bflo(qu[i])) * mula;
        float kv;
        if (gla) kv = (h2 ? bfhi(ku[i]) : bflo(ku[i])) * mulb;
        else kv = mulb - mulb * f[ii];
        qd2[h2] = qv * ea[ii];
        kd2[h2] = kv * eb[ii];
      }
      const unsigned qdp = pack2(qd2[0], qd2[1]);
      kdp[i] = pack2(kd2[0], kd2[1]);
      Qd[16 * th + 2 * i][pc] = (bf16_t)(qdp & 0xffffu);
      Qd[16 * th + 2 * i + 1][pc] = (bf16_t)(qdp >> 16);
      Kd[16 * th + 2 * i][pc] = (bf16_t)(kdp[i] & 0xffffu);
      Kd[16 * th + 2 * i + 1][pc] = (bf16_t)(kdp[i] >> 16);
    }
#pragma unroll
    for (int k4 = 0; k4 < 4; ++k4) *(uint2*)&KdT[c][8 * k4 + 4 * th] = make_uint2(kdp[2 * k4], kdp[2 * k4 + 1]);
  };

  f32x4 S[8];
#pragma unroll
  for (int i = 0; i < 8; ++i) S[i] = (f32x4){0.f, 0.f, 0.f, 0.f};

  auto mload = [&](const char* buf, bf16x8 (&Qf)[2][4], bf16x8 (&Kf)[2][4], bf16x8& Vf) {
    const bf16_t(*Qd)[136] = (const bf16_t(*)[136])buf;
    const bf16_t(*Kd)[136] = (const bf16_t(*)[136])(buf + 8704);
    const bf16_t(*VT)[40] = (const bf16_t(*)[40])(buf + 27648);
#pragma unroll
    for (int it = 0; it < 2; ++it)
#pragma unroll
      for (int ks = 0; ks < 4; ++ks) {
        Qf[it][ks] = *(const bf16x8*)&Qd[16 * it + l16][32 * ks + 8 * g];
        Kf[it][ks] = *(const bf16x8*)&Kd[16 * it + l16][32 * ks + 8 * g];
      }
    Vf = *(const bf16x8*)&VT[16 * (w & 3) + l16][8 * g];
  };
  auto matrix = [&](const char* buf, int p0, const bf16x8 (&Qf)[2][4], const bf16x8 (&Kf)[2][4], const bf16x8& Vf) {
    const bf16_t(*KdT)[40] = (const bf16_t(*)[40])(buf + 17408);
    const float* dec = (const float*)(buf + 32768);
    bf16x8 Sb[4];
#pragma unroll
    for (int ks = 0; ks < 4; ++ks) Sb[ks] = pack_acc2(S[2 * ks], S[2 * ks + 1]);
    f32x4 Oa[2];
    f32x4 att[2][2];
#pragma unroll
    for (int it = 0; it < 2; ++it) {
      Oa[it] = (f32x4){0.f, 0.f, 0.f, 0.f};
#pragma unroll
      for (int ks = 0; ks < 4; ++ks) Oa[it] = MFMA16(Qf[it][ks], Sb[ks], Oa[it]);
    }
#pragma unroll
    for (int jt = 0; jt < 2; ++jt) {
      att[jt][0] = (f32x4){0.f, 0.f, 0.f, 0.f};
      att[jt][1] = (f32x4){0.f, 0.f, 0.f, 0.f};
#pragma unroll
      for (int ks = 0; ks < 4; ++ks) {
        att[jt][0] = MFMA16(Kf[jt][ks], Qf[0][ks], att[jt][0]);
        att[jt][1] = MFMA16(Kf[jt][ks], Qf[1][ks], att[jt][1]);
      }
    }
    bf16x8 KTf[8];
    f32x4 dcv[8];
#pragma unroll
    for (int kt = 0; kt < 8; ++kt) {
      KTf[kt] = *(const bf16x8*)&KdT[16 * kt + l16][8 * g];
      dcv[kt] = *(const f32x4*)&dec[16 * kt + 4 * g];
    }
#pragma unroll
    for (int jt = 0; jt < 2; ++jt)
#pragma unroll
      for (int it = 0; it < 2; ++it)
#pragma unroll
        for (int r = 0; r < 4; ++r) {
          const int j = 16 * jt + 4 * g + r, i = 16 * it + l16;
          const bool keep = (dir == 0) ? (j <= i) : (j >= i);
          att[jt][it][r] = keep ? att[jt][it][r] : 0.f;
        }
#pragma unroll
    for (int it = 0; it < 2; ++it) {
      bf16x8 Pf = pack_acc2(att[0][it], att[1][it]);
      Oa[it] = MFMA16(Pf, Vf, Oa[it]);
    }
    {
      bf16_t* Op = Og + (size_t)p0 * 512;
#pragma unroll
      for (int it = 0; it < 2; ++it)
#pragma unroll
        for (int r = 0; r < 4; ++r) Op[(size_t)(16 * it + r) * 512] = f2bf(Oa[it][r]);
    }
#pragma unroll
    for (int kt = 0; kt < 8; ++kt) {
      f32x4 up = MFMA16(KTf[kt], Vf, S[kt]);
      S[kt] = up * dcv[kt];
    }
  };

  const bool producer = w >= 4;
  ScanRaw ra, rb;
  ra.k0 = ra.k1 = rb.k0 = rb.k1 = make_uint4(0u, 0u, 0u, 0u);
  if (producer) {
    load_raw(ra, 0);
    load_raw(rb, 1);
    prep(ra, smem);
  }
  __syncthreads();
#pragma unroll 1
  for (int ch = 0; ch < 136; ch += 2) {
    if (producer) {
      load_raw(ra, min(ch + 2, 135));
      prep(rb, smem + BUFB);
    } else {
      bf16x8 Qf[2][4], Kf[2][4], Vf;
      mload(smem, Qf, Kf, Vf);
      matrix(smem, chunk_pos(ch), Qf, Kf, Vf);
    }
    __syncthreads();
    if (producer) {
      load_raw(rb, min(ch + 3, 135));
      prep(ra, smem);
    } else {
      bf16x8 Qf[2][4], Kf[2][4], Vf;
      mload(smem + BUFB, Qf, Kf, Vf);
      matrix(smem + BUFB, chunk_pos(ch + 1), Qf, Kf, Vf);
    }
    __syncthreads();
  }
}

DI void scan_item(const Params& p, int u, int item, char* smem) {
  const bool gla = u < 2;
  const int nh = gla ? 2 : 4, nvs = gla ? 4 : 2;
  const int vs = item % nvs;
  const int dir = (item / nvs) & 1;
  const int hl = (item / (2 * nvs)) % nh;
  const int b = item / (2 * nvs * nh);
  if (gla) {
    if (dir == 0) scan_body<true, 0>(p, hl, vs, b, smem);
    else scan_body<true, 1>(p, hl, vs, b, smem);
  } else {
    if (dir == 0) scan_body<false, 0>(p, hl, vs, b, smem);
    else scan_body<false, 1>(p, hl, vs, b, smem);
  }
}

DI void norm_rows(const Params& p, int l, int u, int row0, int nrows) {
  const bool gla = u < 2;
  const int hh = gla ? u : u - 2;
  const int V = gla ? 256 : 128;
  const int tid = tid_(), lane = tid & 63, w = tid >> 6;
  char* R = p.ws + OFF_R;
  const bf16_t* O0 = (const bf16_t*)(R + R_O);
  const bf16_t* O1 = O0 + (size_t)T * 512;
  const bf16_t* G = (const bf16_t*)(R + R_RMG);
  bf16_t* Y = (bf16_t*)(p.ws + (gla ? OFF_YGLA : OFF_YHG));
  const float* gain = (gla ? p.gla_norm_g + l * 256 : p.hgrn_norm_g + l * 128) + ((lane * 8) & (V - 1));
  float gn[8];
#pragma unroll
  for (int j = 0; j < 8; ++j) gn[j] = gain[j];
  for (int rr = w; rr < nrows; rr += 4) {
    const int row = row0 + rr;
    uint4 a = *(const uint4*)(O0 + (size_t)row * 512 + lane * 8);
    uint4 bq = *(const uint4*)(O1 + (size_t)row * 512 + lane * 8);
    uint4 gq = *(const uint4*)(G + (size_t)row * 512 + lane * 8);
    const unsigned au[4] = {a.x, a.y, a.z, a.w}, bu[4] = {bq.x, bq.y, bq.z, bq.w}, gu[4] = {gq.x, gq.y, gq.z, gq.w};
    float o[8], gt[8];
    float ss = 0.f;
#pragma unroll
    for (int i = 0; i < 4; ++i) {
      o[2 * i] = bflo(au[i]) + bflo(bu[i]);
      o[2 * i + 1] = bfhi(au[i]) + bfhi(bu[i]);
      gt[2 * i] = bflo(gu[i]);
      gt[2 * i + 1] = bfhi(gu[i]);
      ss += o[2 * i] * o[2 * i] + o[2 * i + 1] * o[2 * i + 1];
    }
    ss += __shfl_xor(ss, 1);
    ss += __shfl_xor(ss, 2);
    ss += __shfl_xor(ss, 4);
    ss += __shfl_xor(ss, 8);
    if (gla) ss += __shfl_xor(ss, 16);
    const float rstd = rsqrtf(ss / (float)V + EPSN);
    float y[8];
#pragma unroll
    for (int j = 0; j < 8; ++j) y[j] = o[j] * rstd * gn[j] * siluf_(gt[j]);
    *(uint4*)(Y + (size_t)row * 1024 + hh * 512 + lane * 8) =
        make_uint4(pack2(y[0], y[1]), pack2(y[2], y[3]), pack2(y[4], y[5]), pack2(y[6], y[7]));
  }
}

DI void attn_item(const Params& p, int l, int item, char* smem) {
  int b, qb, hk;
  bool isctx;
  if (item < 2048) { isctx = false; hk = item & 1; qb = (item >> 1) & 127; b = item >> 8; }
  else { int it = item - 2048; isctx = true; hk = it & 1; qb = (it >> 1) & 7; b = it >> 4; }
  char* R = p.ws + OFF_R;
  const bf16_t* RM = (const bf16_t*)R;
  const bf16_t* VTg = (const bf16_t*)(R + R_ATT_V) + (size_t)(b * 256 + hk * 128) * SP;
  bf16_t* Y = (bf16_t*)(R + R_O);
  constexpr int ABUF = 18944;
  const int tid = tid_(), lane = tid & 63, w = tid >> 6, l16 = lane & 15, g = lane >> 4;
  const int hq = hk * 4 + w;
  const int qpos0 = isctx ? qb * 32 : 256 + qb * 32;
  const int rowq0 = b * SP + qpos0;
  bf16x8 Qf[2][4];
#pragma unroll
  for (int qt = 0; qt < 2; ++qt)
#pragma unroll
    for (int ks = 0; ks < 4; ++ks)
      Qf[qt][ks] = *(const bf16x8*)(RM + (size_t)(rowq0 + 16 * qt + l16) * 2304 + hq * 128 + 32 * ks + 8 * g);
  float m[2], ls[2];
  const float sink = p.attn_sink[l * 8 + hq];
  m[0] = m[1] = sink;
  ls[0] = ls[1] = (g == 0) ? 1.f : 0.f;
  f32x4 Oa[8][2];
#pragma unroll
  for (int dt = 0; dt < 8; ++dt) { Oa[dt][0] = (f32x4){0.f, 0.f, 0.f, 0.f}; Oa[dt][1] = (f32x4){0.f, 0.f, 0.f, 0.f}; }
  const int bt_lo = isctx ? 1 : max(0, 4 - qb), bt_hi = isctx ? 0 : min(8, 131 - qb);
  const int ntiles = 8 + max(0, bt_hi - bt_lo + 1);
  const int kr = tid >> 4, kd8 = (tid & 15) * 8;
  const int vd = tid >> 2, vpc = tid & 3;
  const int vp0 = 16 * (vpc & 1) + 4 * (vpc >> 1);
  const bf16_t* Kg = RM + (size_t)(b * SP + kr) * 2304 + 1024 + hk * 128 + kd8;
  const bf16_t* Vg = VTg + (size_t)vd * SP + 8 * vpc;
  uint4 rk0, rk1, rv0, rv1;
#define ATT_TLOAD(TI)                                                                              \
  {                                                                                                \
    const int ti_ = (TI);                                                                          \
    const int kpos0_ = ti_ < 8 ? 32 * ti_ : 256 + qb * 32 - 128 + 32 * (bt_lo + ti_ - 8);          \
    rk0 = *(const uint4*)(Kg + (size_t)kpos0_ * 2304);                                             \
    rk1 = *(const uint4*)(Kg + (size_t)(kpos0_ + 16) * 2304);                                      \
    rv0 = *(const uint4*)(Vg + kpos0_);                                                            \
    rv1 = *(const uint4*)(Vg + (size_t)64 * SP + kpos0_);                                          \
  }
#define ATT_TSTORE(BUF)                                                                            \
  {                                                                                                \
    bf16_t(*Ks_)[136] = (bf16_t(*)[136])(BUF);                                                     \
    bf16_t(*VT_)[40] = (bf16_t(*)[40])((BUF) + 8704);                                              \
    *(uint4*)&Ks_[kr][kd8] = rk0;                                                                  \
    *(uint4*)&Ks_[kr + 16][kd8] = rk1;                                                             \
    *(uint2*)&VT_[vd][vp0] = make_uint2(rv0.x, rv0.y);                                             \
    *(uint2*)&VT_[vd][vp0 + 8] = make_uint2(rv0.z, rv0.w);                                         \
    *(uint2*)&VT_[vd + 64][vp0] = make_uint2(rv1.x, rv1.y);                                        \
    *(uint2*)&VT_[vd + 64][vp0 + 8] = make_uint2(rv1.z, rv1.w);                                    \
  }
  ATT_TLOAD(0);
  ATT_TSTORE(smem);
  ATT_TLOAD(min(1, ntiles - 1));
  __syncthreads();
#pragma unroll 1
  for (int ti = 0; ti < ntiles; ++ti) {
    char* buf = smem + (ti & 1) * ABUF;
    if (ti + 1 < ntiles) ATT_TSTORE(smem + ((ti + 1) & 1) * ABUF);
    ATT_TLOAD(min(ti + 2, ntiles - 1));
    int mtype = 0, tk0 = 0;
    if (ti >= 8) {
      const int bt = bt_lo + ti - 8;
      tk0 = qb * 32 - 128 + 32 * bt;
      mtype = (bt == 0) ? 1 : (bt == 8 ? 2 : 0);
    }
    const bf16_t(*Ks)[136] = (const bf16_t(*)[136])buf;
    const bf16_t(*VT)[40] = (const bf16_t(*)[40])(buf + 8704);
    bf16x8 Kf[2][4];
#pragma unroll
    for (int kt = 0; kt < 2; ++kt)
#pragma unroll
      for (int ks = 0; ks < 4; ++ks) Kf[kt][ks] = *(const bf16x8*)&Ks[16 * kt + l16][32 * ks + 8 * g];
    f32x4 st[2][2];
#pragma unroll
    for (int kt = 0; kt < 2; ++kt) { st[kt][0] = (f32x4){0.f, 0.f, 0.f, 0.f}; st[kt][1] = (f32x4){0.f, 0.f, 0.f, 0.f}; }
#pragma unroll
    for (int ks = 0; ks < 4; ++ks)
#pragma unroll
      for (int kt = 0; kt < 2; ++kt) {
        st[kt][0] = MFMA16(Kf[kt][ks], Qf[0][ks], st[kt][0]);
        st[kt][1] = MFMA16(Kf[kt][ks], Qf[1][ks], st[kt][1]);
      }
    bf16x8 Vf[8];
#pragma unroll
    for (int dt = 0; dt < 8; ++dt) Vf[dt] = *(const bf16x8*)&VT[16 * dt + l16][8 * g];
    if (mtype != 0) {
#pragma unroll
      for (int kt = 0; kt < 2; ++kt)
#pragma unroll
        for (int qt = 0; qt < 2; ++qt)
#pragma unroll
          for (int r = 0; r < 4; ++r) {
            const int tk = tk0 + 16 * kt + 4 * g + r, tq = qb * 32 + 16 * qt + l16;
            const bool keep = (mtype == 1) ? (tk >= tq - 128) : (tk <= tq + 128);
            st[kt][qt][r] = keep ? st[kt][qt][r] : -1e30f;
          }
    }
    bf16x8 Pf[2];
#pragma unroll
    for (int qt = 0; qt < 2; ++qt) {
      float tm = fmaxf(fmaxf(fmaxf(st[0][qt][0], st[0][qt][1]), fmaxf(st[0][qt][2], st[0][qt][3])),
                       fmaxf(fmaxf(st[1][qt][0], st[1][qt][1]), fmaxf(st[1][qt][2], st[1][qt][3])));
      tm = fmaxf(tm, __shfl_xor(tm, 16));
      tm = fmaxf(tm, __shfl_xor(tm, 32));
      const float mn = fmaxf(m[qt], tm);
      const float alpha = __expf(m[qt] - mn);
      m[qt] = mn;
      float ps = 0.f;
#pragma unroll
      for (int kt = 0; kt < 2; ++kt)
#pragma unroll
        for (int r = 0; r < 4; ++r) { float pv = __expf(st[kt][qt][r] - mn); st[kt][qt][r] = pv; ps += pv; }
      ls[qt] = ls[qt] * alpha + ps;
#pragma unroll
      for (int dt = 0; dt < 8; ++dt) Oa[dt][qt] *= alpha;
      Pf[qt] = pack_acc2(st[0][qt], st[1][qt]);
    }
#pragma unroll
    for (int dt = 0; dt < 8; ++dt) {
      Oa[dt][0] = MFMA16(Vf[dt], Pf[0], Oa[dt][0]);
      Oa[dt][1] = MFMA16(Vf[dt], Pf[1], Oa[dt][1]);
    }
    __syncthreads();
  }
#undef ATT_TLOAD
#undef ATT_TSTORE
#pragma unroll
  for (int qt = 0; qt < 2; ++qt) {
    float lt = ls[qt];
    lt += __shfl_xor(lt, 16);
    lt += __shfl_xor(lt, 32);
    const float inv = __builtin_amdgcn_rcpf(lt);
    const size_t row = (size_t)(rowq0 + 16 * qt + l16);
#pragma unroll
    for (int dt = 0; dt < 8; ++dt) {
      const int d = 16 * dt + 4 * g;
      uint2 gq = *(const uint2*)(RM + row * 2304 + 1280 + hq * 128 + d);
      float y0 = Oa[dt][qt][0] * inv * siluf_(bflo(gq.x));
      float y1 = Oa[dt][qt][1] * inv * siluf_(bfhi(gq.x));
      float y2 = Oa[dt][qt][2] * inv * siluf_(bflo(gq.y));
      float y3 = Oa[dt][qt][3] * inv * siluf_(bfhi(gq.y));
      *(uint2*)(Y + row * 1024 + hq * 128 + d) = make_uint2(pack2(y0, y1), pack2(y2, y3));
    }
  }
  __syncthreads();
}

DI void gemm_mainloop(f32x16 (&acc)[2][2], const bf16_t* __restrict__ A, int lda, const bf16_t* __restrict__ Bt,
                      int ldb, int K, int m0, int n0, char* smem) {
  typedef bf16_t(*tile_t)[128][72];
  tile_t As = (tile_t)smem;
  tile_t Bs = (tile_t)(smem + 2 * 128 * 72 * 2);
  const int tid = tid_(), lane = tid & 63, w = tid >> 6, wm = w >> 1, wn = w & 1;
  const int l32 = lane & 31, h = lane >> 5;
  const int lr = tid >> 3, lc = (tid & 7) * 8;
  const unsigned voa = (unsigned)(lr * lda + lc) * 2u, vob = (unsigned)(lr * ldb + lc) * 2u;
  const bf16_t* Ab = A + (size_t)m0 * lda;
  const bf16_t* Bb = Bt + (size_t)n0 * ldb;
  const int nk = K >> 6;
  u32x4_t xa[4], xb[4];
#define GEMM_ISSUE(RA, RB, KT)                                                     \
  {                                                                                \
    const int kn_ = min((KT), nk - 1) * 64;                                        \
    _Pragma("unroll") for (int i = 0; i < 4; ++i) {                                \
      gload16(RA[i], Ab + (size_t)(32 * i) * lda + kn_, voa);                      \
      gload16(RB[i], Bb + (size_t)(32 * i) * ldb + kn_, vob);                      \
    }                                                                              \
  }
#define GEMM_WAIT(N, RA, RB)                                                                                   \
  asm volatile("s_waitcnt vmcnt(" #N ")"                                                                       \
               : "+v"(RA[0]), "+v"(RA[1]), "+v"(RA[2]), "+v"(RA[3]), "+v"(RB[0]), "+v"(RB[1]), "+v"(RB[2]), \
                 "+v"(RB[3])                                                                                   \
               :                                                                                               \
               : "memory")
#define GEMM_STORE(RA, RB, BUF)                                                    \
  _Pragma("unroll") for (int i = 0; i < 4; ++i) {                                  \
    *(u32x4_t*)&As[BUF][lr + 32 * i][lc] = RA[i];                                  \
    *(u32x4_t*)&Bs[BUF][lr + 32 * i][lc] = RB[i];                                  \
  }
#define GEMM_COMPUTE(BUF)                                                                                              \
  _Pragma("unroll") for (int ks = 0; ks < 4; ++ks) {                                                                   \
    bf16x8 af[2], bfr[2];                                                                                              \
    _Pragma("unroll") for (int mt = 0; mt < 2; ++mt) af[mt] =                                                          \
        *(const bf16x8*)&As[BUF][64 * wm + 32 * mt + l32][16 * ks + 8 * h];                                           \
    _Pragma("unroll") for (int nt = 0; nt < 2; ++nt) bfr[nt] =                                                         \
        *(const bf16x8*)&Bs[BUF][64 * wn + 32 * nt + l32][16 * ks + 8 * h];                                           \
    _Pragma("unroll") for (int mt = 0; mt < 2; ++mt) _Pragma("unroll") for (int nt = 0; nt < 2; ++nt) acc[mt][nt] =    \
        MFMA32(af[mt], bfr[nt], acc[mt][nt]);                                                                          \
  }
  GEMM_ISSUE(xa, xb, 0);
  GEMM_WAIT(0, xa, xb);
  GEMM_STORE(xa, xb, 0);
  GEMM_ISSUE(xa, xb, 1);
  __syncthreads();
#pragma unroll 1
#define GEMM_FRAGS2(BUF, KS, AF, BF)                                                                                   \
  {                                                                                                                    \
    _Pragma("unroll") for (int mt = 0; mt < 2; ++mt) AF[mt] =                                                          \
        *(const bf16x8*)&As[BUF][64 * wm + 32 * mt + l32][16 * (KS) + 8 * h];                                         \
    _Pragma("unroll") for (int nt = 0; nt < 2; ++nt) BF[nt] =                                                          \
        *(const bf16x8*)&Bs[BUF][64 * wn + 32 * nt + l32][16 * (KS) + 8 * h];                                         \
  }
#define GEMM_MFMAS2(AF, BF)                                                                                            \
  _Pragma("unroll") for (int mt = 0; mt < 2; ++mt) _Pragma("unroll") for (int nt = 0; nt < 2; ++nt) acc[mt][nt] =      \
      MFMA32(AF[mt], BF[nt], acc[mt][nt]);
#define GEMM_HALF2(BUF, OTHER, KNEXT)                                                                                  \
  {                                                                                                                    \
    bf16x8 af0[2], bf0[2];                                                                                             \
    GEMM_FRAGS2(BUF, 0, af0, bf0);                                                                                     \
    GEMM_WAIT(0, xa, xb);                                                                                              \
    GEMM_STORE(xa, xb, OTHER);                                                                                         \
    GEMM_ISSUE(xa, xb, KNEXT);                                                                                         \
    GEMM_MFMAS2(af0, bf0);                                                                                             \
    _Pragma("unroll") for (int ks = 1; ks < 4; ++ks) {                                                                 \
      bf16x8 af[2], bfr[2];                                                                                            \
      GEMM_FRAGS2(BUF, ks, af, bfr);                                                                                   \
      GEMM_MFMAS2(af, bfr);                                                                                            \
    }                                                                                                                  \
  }
  for (int kt = 0; kt < nk; kt += 2) {
    GEMM_HALF2(0, 1, kt + 2);
    __syncthreads();
    GEMM_HALF2(1, 0, kt + 3);
    __syncthreads();
  }
#undef GEMM_FRAGS2
#undef GEMM_MFMAS2
#undef GEMM_HALF2
  GEMM_WAIT(0, xa, xb);
#undef GEMM_ISSUE
#undef GEMM_WAIT
#undef GEMM_STORE
#undef GEMM_COMPUTE
}

DI void zero_acc22(f32x16 (&acc)[2][2]) {
#pragma unroll
  for (int mt = 0; mt < 2; ++mt)
#pragma unroll
    for (int nt = 0; nt < 2; ++nt)
#pragma unroll
      for (int i = 0; i < 16; ++i) acc[mt][nt][i] = 0.f;
}

DI void inproj_tile_small(const Params& p, int l, int u, int mtile, int ntile, char* smem) {
  const int ubase = (u < 2) ? u * 2048 : (u < 4 ? 4096 + (u - 2) * 2560 : 9216);
  f32x16 acc[2][2];
  zero_acc22(acc);
  const int m0 = mtile * 128, n0 = ntile * 128;
  gemm_mainloop(acc, (const bf16_t*)(p.ws + OFF_H), 1024, (const bf16_t*)(p.ws + OFF_WINT) + (size_t)ubase * 1024, 1024,
                1024, m0, n0, smem);
  const int tid = tid_(), lane = tid & 63, w = tid >> 6, wm = w >> 1, wn = w & 1;
  const int l32 = lane & 31, h = lane >> 5;
  const int b = m0 / SP;
  const int posb = (m0 % SP) + 64 * wm + 4 * h;
  const int rowb = m0 + 64 * wm + 4 * h;
  const int jb = n0 + 64 * wn;
  char* R = p.ws + OFF_R;
  if (u < 4) {
    const bool gla = u < 2;
    const int hh = gla ? u : u - 2;
    const int ntr = gla ? 1536 : 2048;
    bf16_t* TR = (bf16_t*)(R + R_TR) + (size_t)b * ntr * SP;
    bf16_t* RMG = (bf16_t*)(R + R_RMG);
#pragma unroll
    for (int nt = 0; nt < 2; ++nt) {
      const int j = jb + 32 * nt + l32;
      int mode, tcol = 0;
      float aux = 0.f;
      if (gla) {
        if (j < 256) { mode = 1; tcol = j; }
        else if (j < 1024) { mode = 0; tcol = j; }
        else if (j < 1536) { mode = 2; tcol = j - 1024; }
        else { mode = 3; tcol = j - 512; int d = (j - 1536) >> 8, cc = (j - 1536) & 255;
               aux = p.gla_b_a2[(size_t)(l * 2 + d) * 512 + hh * 256 + cc]; }
      } else {
        if (j < 512) { mode = 0; tcol = j; }
        else if (j < 1536) { mode = 4; tcol = j; int d = (j - 512) >> 9, cc = (j - 512) & 511;
                             aux = ((const float*)(p.ws + OFF_LB))[(size_t)(l * 2 + d) * 1024 + hh * 512 + cc]; }
        else if (j < 2048) { mode = 0; tcol = j; }
        else { mode = 2; tcol = j - 2048; }
      }
#pragma unroll
      for (int mt = 0; mt < 2; ++mt)
#pragma unroll
        for (int q = 0; q < 4; ++q) {
          float v[4];
#pragma unroll
          for (int e = 0; e < 4; ++e) v[e] = acc[mt][nt][4 * q + e];
          if (mode == 1) {
#pragma unroll
            for (int e = 0; e < 4; ++e) v[e] *= 0.08838834764831845f;
          } else if (mode == 3) {
#pragma unroll
            for (int e = 0; e < 4; ++e) v[e] = logsigf_(v[e] + aux) * (1.f / 16.f);
          } else if (mode == 4) {
#pragma unroll
            for (int e = 0; e < 4; ++e) {
              v[e] = (aux > 0.f) ? __logf(aux + (1.f - aux) * sigmoidf_(v[e])) : logsigf_(v[e]);
            }
          }
          if (mode == 2) {
#pragma unroll
            for (int e = 0; e < 4; ++e) RMG[(size_t)(rowb + 32 * mt + 8 * q + e) * 512 + tcol] = f2bf(v[e]);
          } else {
            *(uint2*)(TR + (size_t)tcol * SP + posb + 32 * mt + 8 * q) = make_uint2(pack2(v[0], v[1]), pack2(v[2], v[3]));
          }
        }
    }
  } else {
    bf16_t* RM = (bf16_t*)R;
    bf16_t* VT = (bf16_t*)(R + R_ATT_V) + (size_t)b * 256 * SP;
    const float* rt = (const float*)(p.ws + OFF_ROPE);
    if (jb < 1280) {
      const float qs = (jb < 1024) ? 0.08838834764831845f : 1.f;
      const int half = (jb >> 6) & 1;
#pragma unroll
      for (int mt = 0; mt < 2; ++mt)
#pragma unroll
        for (int i = 0; i < 16; ++i) {
          const int rr = 32 * mt + 8 * (i >> 2) + (i & 3);
          const int pos = posb + rr;
          const float u1 = acc[mt][0][i], u2 = acc[mt][1][i];
          float o1 = u1, o2 = u2;
          if (pos >= 256) {
            const int t = pos - 256;
            const int pp = half ? (t & 63) : (t >> 6);
            const float2 cs = *(const float2*)(rt + (size_t)(pp * 32 + l32) * 2);
            o1 = u1 * cs.x - u2 * cs.y;
            o2 = u2 * cs.x + u1 * cs.y;
          }
          bf16_t* dst = RM + (size_t)(rowb + rr) * 2304 + jb + l32;
          dst[0] = f2bf(o1 * qs);
          dst[32] = f2bf(o2 * qs);
        }
    } else {
#pragma unroll
      for (int nt = 0; nt < 2; ++nt) {
        const int j = jb + 32 * nt + l32;
#pragma unroll
        for (int mt = 0; mt < 2; ++mt)
#pragma unroll
          for (int q = 0; q < 4; ++q) {
            if (j < 1536) {
              *(uint2*)(VT + (size_t)(j - 1280) * SP + posb + 32 * mt + 8 * q) =
                  make_uint2(pack2(acc[mt][nt][4 * q], acc[mt][nt][4 * q + 1]), pack2(acc[mt][nt][4 * q + 2], acc[mt][nt][4 * q + 3]));
            } else {
#pragma unroll
              for (int e = 0; e < 4; ++e)
                RM[(size_t)(rowb + 32 * mt + 8 * q + e) * 2304 + (j - 256)] = f2bf(acc[mt][nt][4 * q + e]);
            }
          }
      }
    }
  }
}

DI void merge_tile(const Params& p, int mtile, int ntile, char* smem) {
  const int m0 = mtile * 128, n0 = ntile * 128;
  const int tid = tid_(), lane = tid & 63, w = tid >> 6, wm = w >> 1, wn = w & 1, l32 = lane & 31, h = lane >> 5;
  float4* const park0 = (float4*)(p.ws + OFF_R + SZ_ACT) + (size_t)blockIdx.x * (48 * 512) + (size_t)(threadIdx.x >> 8) * 6144 + tid;
#pragma unroll 1
  for (int pass = 0; pass < 6; ++pass) {
    const int n = pass >> 1, kind = pass & 1;
    const bf16_t* A;
    const bf16_t* B;
    if (kind == 0) {
      A = (const bf16_t*)(p.ws + OFF_H);
      B = (const bf16_t*)(p.ws + OFF_WINT) + (size_t)(11776 + n * 1024) * 1024;
    } else {
      A = (n == 0) ? (const bf16_t*)(p.ws + OFF_YGLA)
                   : (n == 1 ? (const bf16_t*)(p.ws + OFF_YHG) : (const bf16_t*)(p.ws + OFF_R + R_O));
      B = (const bf16_t*)(p.ws + OFF_WBRT) + (size_t)n * 1024 * 1024;
    }
    f32x16 acc[2][2];
    zero_acc22(acc);
    gemm_mainloop(acc, A, 1024, B, 1024, 1024, m0, n0, smem);
    int zz = 0;
    asm volatile("" : "+v"(zz));
    float4* const park = park0 + zz;
    if (kind == 0) {
#pragma unroll
      for (int mt = 0; mt < 2; ++mt)
#pragma unroll
        for (int nt = 0; nt < 2; ++nt)
#pragma unroll
          for (int q2 = 0; q2 < 2; ++q2) {
            uint4 gq;
            gq.x = pack2(sigmoidf_(acc[mt][nt][8 * q2 + 0]), sigmoidf_(acc[mt][nt][8 * q2 + 1]));
            gq.y = pack2(sigmoidf_(acc[mt][nt][8 * q2 + 2]), sigmoidf_(acc[mt][nt][8 * q2 + 3]));
            gq.z = pack2(sigmoidf_(acc[mt][nt][8 * q2 + 4]), sigmoidf_(acc[mt][nt][8 * q2 + 5]));
            gq.w = pack2(sigmoidf_(acc[mt][nt][8 * q2 + 6]), sigmoidf_(acc[mt][nt][8 * q2 + 7]));
            *(uint4*)(park + (16 + (mt * 2 + nt) * 2 + q2) * 256) = gq;
            asm volatile("" ::: "memory");
          }
    } else {
#pragma unroll
      for (int mt = 0; mt < 2; ++mt)
#pragma unroll
        for (int nt = 0; nt < 2; ++nt)
#pragma unroll
          for (int q2 = 0; q2 < 2; ++q2) {
            const uint4 gq = *(const uint4*)(park + (16 + (mt * 2 + nt) * 2 + q2) * 256);
            const unsigned gu[4] = {gq.x, gq.y, gq.z, gq.w};
#pragma unroll
            for (int qq = 0; qq < 2; ++qq) {
              const int q = 2 * q2 + qq;
              float4 t;
              t.x = bflo(gu[2 * qq]) * acc[mt][nt][4 * q];
              t.y = bfhi(gu[2 * qq]) * acc[mt][nt][4 * q + 1];
              t.z = bflo(gu[2 * qq + 1]) * acc[mt][nt][4 * q + 2];
              t.w = bfhi(gu[2 * qq + 1]) * acc[mt][nt][4 * q + 3];
              float4* pk = park + ((mt * 2 + nt) * 4 + q) * 256;
              if (n > 0) { float4 o = *pk; t.x += o.x; t.y += o.y; t.z += o.z; t.w += o.w; }
              if (n < 2) *pk = t;
              else {
                bf16_t* M = (bf16_t*)(p.ws + OFF_R) + zz + (size_t)(m0 + 64 * wm + 32 * mt + 8 * q + 4 * h) * 1024 + n0 + 64 * wn + 32 * nt + l32;
                M[0] = f2bf(t.x); M[1024] = f2bf(t.y); M[2048] = f2bf(t.z); M[3072] = f2bf(t.w);
              }
            }
            asm volatile("" ::: "memory");
          }
    }
  }
}

DI void merge_tile_big(const Params& p, int mtile, int ntile, char* smem) {
  const int m0 = mtile * 256, n0 = ntile * 256;
  const int tid = tid512_(), lane = tid & 63, w = tid >> 6, wm = w >> 2, wn = w & 3, l32 = lane & 31, h = lane >> 5;
  float4* const park0 = (float4*)(p.ws + OFF_R + SZ_ACT) + (size_t)blockIdx.x * (48 * 512) + tid;
#pragma unroll 1
  for (int pass = 0; pass < 6; ++pass) {
    const int n = pass >> 1, kind = pass & 1;
    const bf16_t* A;
    const bf16_t* B;
    if (kind == 0) {
      A = (const bf16_t*)(p.ws + OFF_H);
      B = (const bf16_t*)(p.ws + OFF_WINT) + (size_t)(11776 + n * 1024) * 1024;
    } else {
      A = (n == 0) ? (const bf16_t*)(p.ws + OFF_YGLA)
                   : (n == 1 ? (const bf16_t*)(p.ws + OFF_YHG) : (const bf16_t*)(p.ws + OFF_R + R_O));
      B = (const bf16_t*)(p.ws + OFF_WBRT) + (size_t)n * 1024 * 1024;
    }
    f32x16 acc[4][2];
    zero_acc<2>(acc);
    gemm512<2>(acc, A, B, m0, n0, smem);
    int zz = 0;
    asm volatile("" : "+v"(zz));
    float4* const park = park0 + zz;
    if (kind == 0) {
#pragma unroll
      for (int mt = 0; mt < 4; ++mt)
#pragma unroll
        for (int nt = 0; nt < 2; ++nt)
#pragma unroll
          for (int q2 = 0; q2 < 2; ++q2) {
            uint4 gq;
            gq.x = pack2(sigmoidf_(acc[mt][nt][8 * q2 + 0]), sigmoidf_(acc[mt][nt][8 * q2 + 1]));
            gq.y = pack2(sigmoidf_(acc[mt][nt][8 * q2 + 2]), sigmoidf_(acc[mt][nt][8 * q2 + 3]));
            gq.z = pack2(sigmoidf_(acc[mt][nt][8 * q2 + 4]), sigmoidf_(acc[mt][nt][8 * q2 + 5]));
            gq.w = pack2(sigmoidf_(acc[mt][nt][8 * q2 + 6]), sigmoidf_(acc[mt][nt][8 * q2 + 7]));
            *(uint4*)(park + (32 + (mt * 2 + nt) * 2 + q2) * 512) = gq;
            asm volatile("" ::: "memory");
          }
    } else {
#pragma unroll
      for (int mt = 0; mt < 4; ++mt)
#pragma unroll
        for (int nt = 0; nt < 2; ++nt)
#pragma unroll
          for (int q2 = 0; q2 < 2; ++q2) {
            const uint4 gq = *(const uint4*)(park + (32 + (mt * 2 + nt) * 2 + q2) * 512);
            const unsigned gu[4] = {gq.x, gq.y, gq.z, gq.w};
#pragma unroll
            for (int qq = 0; qq < 2; ++qq) {
              const int q = 2 * q2 + qq;
              float4 t;
              t.x = bflo(gu[2 * qq]) * acc[mt][nt][4 * q];
              t.y = bfhi(gu[2 * qq]) * acc[mt][nt][4 * q + 1];
              t.z = bflo(gu[2 * qq + 1]) * acc[mt][nt][4 * q + 2];
              t.w = bfhi(gu[2 * qq + 1]) * acc[mt][nt][4 * q + 3];
              float4* pk = park + ((mt * 2 + nt) * 4 + q) * 512;
              if (n > 0) { float4 o = *pk; t.x += o.x; t.y += o.y; t.z += o.z; t.w += o.w; }
              if (n < 2) *pk = t;
              else {
                bf16_t* M = (bf16_t*)(p.ws + OFF_R) + (size_t)(m0 + zz + 128 * wm + 32 * mt + 8 * q + 4 * h) * 1024 + n0 + 64 * wn + 32 * nt + l32;
                M[0] = f2bf(t.x); M[1024] = f2bf(t.y); M[2048] = f2bf(t.z); M[3072] = f2bf(t.w);
              }
            }
            asm volatile("" ::: "memory");
          }
    }
  }
}

DI void outproj_tile(const Params& p, int l, int mtile, int ntile, char* smem) {
  const int m0 = mtile * 128, n0 = ntile * 128;
  f32x16 acc[2][2];
  zero_acc22(acc);
  gemm_mainloop(acc, (const bf16_t*)(p.ws + OFF_R), 1024, (const bf16_t*)(p.ws + OFF_WOUTT), 1024, 1024, m0, n0, smem);
  const int tid = tid_(), lane = tid & 63, w = tid >> 6, wm = w >> 1, wn = w & 1, l32 = lane & 31, h = lane >> 5;
  const int b = m0 / SP, pos0 = m0 % SP;
  const bool isctx = pos0 < 256;
  const float* gate = (const float*)(p.ws + OFF_MOD) + ((size_t)(l * 9 + (isctx ? 8 : b))) * 3072 + 2048;
  const float* src;
  float* dst;
  if (isctx) {
    src = p.ctx + (size_t)(b * 256 + pos0) * 1024;
    dst = (float*)(p.ws + OFF_CTX1) + (size_t)(b * 256 + pos0) * 1024;
  } else {
    src = (l == 0 ? p.x : (const float*)p.out) + (size_t)(b * 4096 + pos0 - 256) * 1024;
    dst = p.out + (size_t)(b * 4096 + pos0 - 256) * 1024;
  }
#pragma unroll
  for (int nt = 0; nt < 2; ++nt) {
    const int col = n0 + 64 * wn + 32 * nt + l32;
    const float gt = gate[col];
#pragma unroll
    for (int mt = 0; mt < 2; ++mt)
#pragma unroll
      for (int i = 0; i < 16; ++i) {
        const size_t off = (size_t)(64 * wm + 32 * mt + 8 * (i >> 2) + 4 * h + (i & 3)) * 1024 + col;
        dst[off] = src[off] + gt * acc[mt][nt][i];
      }
  }
}

DI void final_rows(const Params& p, int row0, int nrows) {
  const int tid = tid_(), lane = tid & 63, w = tid >> 6;
  for (int rr = w; rr < nrows; rr += 4) {
    float* rp = p.out + (size_t)(row0 + rr) * 1024;
    float4 v[4];
    float ss = 0.f;
#pragma unroll
    for (int i = 0; i < 4; ++i) {
      v[i] = *(const float4*)(rp + i * 256 + lane * 4);
      ss += v[i].x * v[i].x + v[i].y * v[i].y + v[i].z * v[i].z + v[i].w * v[i].w;
    }
#pragma unroll
    for (int o = 32; o >= 1; o >>= 1) ss += __shfl_xor(ss, o);
    const float rstd = rsqrtf(ss * (1.f / 1024.f) + EPSN);
#pragma unroll
    for (int i = 0; i < 4; ++i) {
      float4 g4 = *(const float4*)(p.final_g + i * 256 + lane * 4);
      float4 o4 = make_float4(v[i].x * rstd * g4.x, v[i].y * rstd * g4.y, v[i].z * rstd * g4.z, v[i].w * rstd * g4.w);
      *(float4*)(rp + i * 256 + lane * 4) = o4;
    }
  }
}

#define XB_TMO      128
#define XB_XCNT(j)  (256  + 64 * (j))
#define XB_XSUB(j)  (1280 + 64 * (j))
#define XB_XGEN(j)  (2304 + 64 * (j))
#define XB_TOP      3328
#define XB_TOPGEN   3392
#define XCD_BAR_WORDS 3456
#define XB_SPIN_CAP (1u << 22)
#define LAS __attribute__((address_space(3)))
DI unsigned xb_ld(unsigned* p) { return __hip_atomic_load(p, __ATOMIC_RELAXED, __HIP_MEMORY_SCOPE_AGENT); }
DI unsigned xb_add(unsigned* p, unsigned v) { return __hip_atomic_fetch_add(p, v, __ATOMIC_RELAXED, __HIP_MEMORY_SCOPE_AGENT); }
DI unsigned xb_xcc_id() { return (unsigned)__builtin_amdgcn_s_getreg((3 << 11) | 20) & 0xFu; }
#define XB_SPIN(cond, bar) do { unsigned _sp = 0; while (cond) { __builtin_amdgcn_s_sleep(1); \
    if ((++_sp & 255u) == 0u) { if (xb_ld(&(bar)[XB_TMO])) break; if (_sp > XB_SPIN_CAP) { atomicAdd(&(bar)[XB_TMO], 1u); break; } } } } while (0)
struct XcdBarrier { unsigned* bar; unsigned x; volatile LAS unsigned* st; };
DI XcdBarrier xcd_barrier_post(unsigned* bar, volatile LAS unsigned* st) {
  XcdBarrier b; b.bar = bar; b.x = xb_xcc_id(); b.st = st;
  if (threadIdx.x == 0) (void)xb_add(&bar[XB_XCNT(b.x)], 1u);
  return b;
}
DI void xcd_barrier_complete(unsigned* bar, unsigned x, unsigned& nloc, unsigned& nx) {
  const unsigned G = gridDim.x * gridDim.y * gridDim.z;
  unsigned sum, cnt, mine, sp = 0u;
  for (;;) {
    sum = 0u; cnt = 0u; mine = 0u;
#pragma unroll
    for (unsigned j = 0; j < 16; ++j) { const unsigned c = xb_ld(&bar[XB_XCNT(j)]); sum += c; cnt += (c > 0u) ? 1u : 0u; mine = (j == x) ? c : mine; }
    if (sum == G) break;
    __builtin_amdgcn_s_sleep(1);
    if ((++sp & 255u) == 0u) { if (xb_ld(&bar[XB_TMO])) break; if (sp > XB_SPIN_CAP) { atomicAdd(&bar[XB_TMO], 1u); break; } }
  }
  nloc = mine > 0u ? mine : 1u; nx = cnt > 0u ? cnt : 1u;
}
DI void xcd_barrier(const XcdBarrier& b) {
  asm volatile("s_waitcnt vmcnt(0)" ::: "memory");
  __syncthreads();
  if (threadIdx.x == 0) {
    size_t zb = 0;
    asm volatile("" : "+s"(zb));
    unsigned* bar = b.bar + zb;
    unsigned bx = b.x;
    asm volatile("" : "+s"(bx));
    __builtin_amdgcn_s_waitcnt(0);
    unsigned nloc = b.st[0], nx = b.st[1];
    if (nloc == 0u) { xcd_barrier_complete(bar, bx, nloc, nx); b.st[0] = nloc; b.st[1] = nx; }
    const unsigned old = xb_add(&bar[XB_XSUB(bx)], 1u);
    const unsigned gen = old / nloc;
    if (old + 1u == (gen + 1u) * nloc) {
      __builtin_amdgcn_fence(__ATOMIC_RELEASE, "agent");
      asm volatile("s_waitcnt vmcnt(0)" ::: "memory");
      const unsigned og = xb_add(&bar[XB_TOP], 1u);
      const unsigned tg = og / nx;
      if (og + 1u == (tg + 1u) * nx) xb_add(&bar[XB_TOPGEN], 1u);
      else XB_SPIN(xb_ld(&bar[XB_TOPGEN]) == tg, bar);
      __builtin_amdgcn_fence(__ATOMIC_ACQUIRE, "agent");
      xb_add(&bar[XB_XGEN(bx)], 1u);
      asm volatile("s_waitcnt vmcnt(0)" ::: "memory");
    } else {
      XB_SPIN(xb_ld(&bar[XB_XGEN(bx)]) == gen, bar);
      __builtin_amdgcn_fence(__ATOMIC_ACQUIRE, "agent");
      asm volatile("s_waitcnt vmcnt(0)" ::: "memory");
    }
  }
  __syncthreads();
}

DI Params launder(Params p) {
  size_t z = 0;
  asm volatile("" : "+s"(z));
  p.ws += z;
  p.out += z;
  p.x += z;
  p.w_in += z;
  return p;
}

__global__ void __launch_bounds__(512) fwd_megakernel(Params p) {
  cg::grid_group grid = cg::this_grid();
  __shared__ __attribute__((aligned(16))) char smem_all[147456];
  const int half = __builtin_amdgcn_readfirstlane((int)(threadIdx.x >> 8));
  char* smem = smem_all + half * 73728;
  const int rnb = gridDim.x, rbid = blockIdx.x;
  const int nb = 2 * rnb, bid = 2 * rbid + half;
  __shared__ uint4 xb_words;
  if (threadIdx.x == 0) xb_words = make_uint4(0u, 0u, 0u, 0u);
  __syncthreads();
  const XcdBarrier xb = xcd_barrier_post((unsigned*)(p.ws + OFF_BAR), (volatile LAS unsigned*)&xb_words);

  for (int it = bid; it < 192 + NW_ITEMS + 2; it += nb) {
    if (it < 192) modp_item(p, it, smem);
    else if (it < 192 + NW_ITEMS) weight_item(p, 0, it - 192, smem);
    else if (it == 192 + NW_ITEMS) tables_item(p);
  }
  grid.sync();
  {
    float* mod = (float*)(p.ws + OFF_MOD);
    const float* mp = (const float*)(p.ws + OFF_MODP);
    for (int e = rbid * 512 + threadIdx.x; e < 2 * 9 * 3072; e += rnb * 512) {
      const int l = e / (9 * 3072), rj = e % (9 * 3072), j = rj % 3072;
      float s = p.b_ada[l * 3072 + j];
#pragma unroll
      for (int kp = 0; kp < 8; ++kp) s += mp[(size_t)(kp * 2 + l) * 9 * 3072 + rj];
      mod[e] = s;
    }
  }
  xcd_barrier(xb);

  for (int l = 0; l < 2; ++l) {
    {
      const Params q = launder(p);
      const int nwi = (l == 1) ? NW_ITEMS : 0;
      for (int it = bid; it < 272 + nwi; it += nb) {
        if (it < 272) h_item(q, l, it);
        else weight_item(q, 1, it - 272, smem);
      }
    }
    xcd_barrier(xb);
    for (int u = 0; u < 5; ++u) {
      {
        const Params q = launder(p);
        const int ntn = (u < 2) ? 8 : 10;
        const int nh = ntn >> 1, g = rbid & 1, mq = (rbid >> 1) & 3, xw = rnb >> 3;
        for (int t = rbid >> 3; t < 32 * nh; t += xw) inproj_tile(q, l, u, mq * 32 + t / nh, g * nh + t % nh, smem_all);
        const int nts = 2 * ntn;
        for (int it = bid; it < 16 * nts; it += nb) inproj_tile_small(q, l, u, 256 + it / nts, it % nts, smem);
      }
      xcd_barrier(xb);
      if (u < 4) {
        {
          const Params q = launder(p);
          for (int it = rbid; it < 128; it += rnb) scan_item(q, u, it, smem_all);
        }
        xcd_barrier(xb);
        {
          const Params q = launder(p);
          for (int it = bid; it < T / 16; it += nb) norm_rows(q, l, u, it * 16, 16);
        }
        xcd_barrier(xb);
      } else {
        const Params q = launder(p);
        const int nit = (l == 0) ? 2048 + 128 : 2048;
        for (int it = bid; it < nit; it += nb) attn_item(q, l, it, smem);
        xcd_barrier(xb);
      }
    }
    {
      const Params q = launder(p);
      for (int t = rbid; t < 512; t += rnb) {
        const int k = t >> 2;
        const int mt = (l == 1) ? (k >> 4) * 17 + 1 + (k & 15) : k;
        merge_tile_big(q, mt, t & 3, smem_all);
      }
    }
    xcd_barrier(xb);
    if (l == 0) {
      {
        const Params q = launder(p);
        for (int it = bid; it < 128 + 2048; it += nb) {
          if (it < 128) merge_tile(q, 256 + (it >> 3), it & 7, smem);
          else outproj_tile(q, l, (it - 128) >> 3, (it - 128) & 7, smem);
        }
      }
      xcd_barrier(xb);
      {
        const Params q = launder(p);
        for (int it = bid; it < 128; it += nb) outproj_tile(q, l, 256 + (it >> 3), it & 7, smem);
      }
    } else {
      const Params q = launder(p);
      const int xw = nb >> 3, ng = bid & 3, mh = (bid >> 2) & 1;
      for (int j = bid >> 3; j < 272; j += xw) {
        const int mt = mh * 136 + (j >> 1), nt = ng * 2 + (j & 1);
        if ((mt % 34) < 2) continue;
        outproj_tile(q, l, mt, nt, smem);
      }
    }
    xcd_barrier(xb);
  }
  {
    const Params q = launder(p);
    for (int it = bid; it < 32768 / 16; it += nb) final_rows(q, it * 16, 16);
  }
}

extern "C" void kernel_launch(void* const* d_in, const int* in_sizes, int n_in, void* d_out, int out_size, void* d_ws,
                              size_t ws_size, hipStream_t stream) {
  static int grid_blocks = 0;
  if (!grid_blocks) {
    int dev = 0, cus = 0, per_cu = 0;
    hipGetDevice(&dev);
    hipDeviceGetAttribute(&cus, hipDeviceAttributeMultiprocessorCount, dev);
    hipOccupancyMaxActiveBlocksPerMultiprocessor(&per_cu, fwd_megakernel, 512, 0);
    if (per_cu < 1) per_cu = 1;
    if (per_cu > 1) per_cu = 1;
    grid_blocks = cus * per_cu;
  }
  if (ws_size < WS_NEED) fprintf(stderr, "workspace too small: %zu < %zu\n", ws_size, (size_t)WS_NEED);
  Params p{};
  p.x = (const float*)d_in[0]; p.c = (const float*)d_in[1]; p.ctx = (const float*)d_in[2]; p.c_ctx = (const float*)d_in[3];
  p.norm_g = (const float*)d_in[4]; p.w_ada = (const float*)d_in[5]; p.b_ada = (const float*)d_in[6];
  p.w_in = (const float*)d_in[7]; p.gla_w_a2 = (const float*)d_in[8]; p.gla_b_a2 = (const float*)d_in[9];
  p.gla_norm_g = (const float*)d_in[10]; p.hgrn_lb = (const float*)d_in[11]; p.hgrn_norm_g = (const float*)d_in[12];
  p.attn_sink = (const float*)d_in[13]; p.w_branch = (const float*)d_in[14]; p.w_out = (const float*)d_in[15];
  p.final_g = (const float*)d_in[16];
  p.out = (float*)d_out;
  p.ws = (char*)d_ws;
  (void)hipMemsetAsync((char*)d_ws + OFF_BAR, 0, XCD_BAR_WORDS * 4, stream);
  void* args[] = {&p};
  hipError_t e = hipLaunchCooperativeKernel((void*)fwd_megakernel, dim3(grid_blocks), dim3(512), args, 0, stream);
  if (e != hipSuccess) fprintf(stderr, "cooperative launch failed: %s (grid %d)\n", hipGetErrorString(e), grid_blocks);
}
```

```cpp
#include <hip/hip_runtime.h>
#include <hip/hip_cooperative_groups.h>
#include <cstdio>
namespace cg = cooperative_groups;

typedef unsigned short bf16_t;
using bf16x8 = __attribute__((ext_vector_type(8))) short;
using f32x4 = __attribute__((ext_vector_type(4))) float;
using f32x16 = __attribute__((ext_vector_type(16))) float;
#define DI __device__ __forceinline__
#define MFMA16(a, b, c) __builtin_amdgcn_mfma_f32_16x16x32_bf16((a), (b), (c), 0, 0, 0)
#define MFMA32(a, b, c) __builtin_amdgcn_mfma_f32_32x32x16_bf16((a), (b), (c), 0, 0, 0)

typedef __bf16 bf16v2_t __attribute__((ext_vector_type(2)));
typedef float f32v2_t __attribute__((ext_vector_type(2)));
DI unsigned pack2(float a, float b) { f32v2_t v = {a, b}; bf16v2_t r = __builtin_convertvector(v, bf16v2_t); return __builtin_bit_cast(unsigned, r); }
DI bf16_t f2bf(float x) { return (bf16_t)(pack2(x, 0.f) & 0xffffu); }
DI float bf2f(bf16_t h) { return __uint_as_float(((unsigned)h) << 16); }
DI float bflo(unsigned u) { return __uint_as_float(u << 16); }
DI float bfhi(unsigned u) { return __uint_as_float(u & 0xffff0000u); }
DI float sigmoidf_(float z) { return __builtin_amdgcn_rcpf(1.f + __expf(-z)); }
DI float siluf_(float z) { return z * __builtin_amdgcn_rcpf(1.f + __expf(-z)); }
DI float logsigf_(float z) { return fminf(z, 0.f) - __logf(1.f + __expf(-fabsf(z))); }

DI int tid_() { int t = threadIdx.x & 255; asm volatile("" : "+v"(t)); __builtin_assume(t >= 0 && t < 256); return t; }
DI int tid512_() { int t = threadIdx.x; asm volatile("" : "+v"(t)); __builtin_assume(t >= 0 && t < 512); return t; }

constexpr int T = 34816;
constexpr int SP = 4352;
constexpr int NWIN = 14848;
constexpr int NIN = 13856;
constexpr float EPSN = 1e-6f;

constexpr size_t SZ_ACT = (size_t)T * 1024 * 2;
constexpr size_t OFF_WINT = 0;
constexpr size_t OFF_WBRT = OFF_WINT + (size_t)NWIN * 1024 * 2;
constexpr size_t OFF_WOUTT = OFF_WBRT + (size_t)3 * 1024 * 1024 * 2;
constexpr size_t OFF_H = OFF_WOUTT + (size_t)1024 * 1024 * 2;
constexpr size_t OFF_YGLA = OFF_H + SZ_ACT;
constexpr size_t OFF_YHG = OFF_YGLA + SZ_ACT;
constexpr size_t OFF_MODP = OFF_YHG + SZ_ACT;
constexpr size_t OFF_MOD = OFF_MODP + (size_t)8 * 2 * 9 * 3072 * 4;
constexpr size_t OFF_LB = OFF_MOD + (size_t)2 * 9 * 3072 * 4;
constexpr size_t OFF_ROPE = OFF_LB + (size_t)2 * 2 * 1024 * 4;
constexpr size_t OFF_BAR = OFF_ROPE + (size_t)64 * 32 * 2 * 4;
constexpr size_t OFF_CTX1 = OFF_BAR + 16384;
constexpr size_t OFF_R = OFF_CTX1 + (size_t)2048 * 1024 * 4;
constexpr size_t R_TR = 0;
constexpr size_t R_RMG = (size_t)8 * 2048 * SP * 2;
constexpr size_t R_O = R_RMG + (size_t)T * 512 * 2;
constexpr size_t R_ATT_V = (size_t)T * 2304 * 2;
constexpr size_t WS_NEED = OFF_R + R_O + SZ_ACT;

struct Params {
  const float *x, *c, *ctx, *c_ctx, *norm_g, *w_ada, *b_ada, *w_in, *gla_w_a2, *gla_b_a2, *gla_norm_g, *hgrn_lb,
      *hgrn_norm_g, *attn_sink, *w_branch, *w_out, *final_g;
  float* out;
  char* ws;
};

DI void modp_item(const Params& p, int item, char* smem) {
  const int kp = item & 7, jb = (item >> 3) % 12, l = item / 96;
  float(*s)[128] = (float(*)[128])smem;
  const int tid = tid_();
  for (int e = tid; e < 9 * 128; e += 256) {
    int r = e >> 7, k = e & 127;
    float v = (r < 8) ? p.c[r * 1024 + kp * 128 + k] : p.c_ctx[kp * 128 + k];
    s[r][k] = siluf_(v);
  }
  __syncthreads();
  float acc[9];
#pragma unroll
  for (int r = 0; r < 9; ++r) acc[r] = 0.f;
  const float* w = p.w_ada + (size_t)l * 1024 * 3072 + (size_t)(kp * 128) * 3072 + jb * 256 + tid;
#pragma unroll 4
  for (int k = 0; k < 128; ++k) {
    float wv = w[(size_t)k * 3072];
#pragma unroll
    for (int r = 0; r < 9; ++r) acc[r] += s[r][k] * wv;
  }
  float* mp = (float*)(p.ws + OFF_MODP) + ((size_t)(kp * 2 + l) * 9) * 3072 + jb * 256 + tid;
#pragma unroll
  for (int r = 0; r < 9; ++r) mp[(size_t)r * 3072] = acc[r];
  __syncthreads();
}

DI void tables_item(const Params& p) {
  const int tid = tid_();
  float* lb = (float*)(p.ws + OFF_LB);
  for (int e = tid; e < 2048; e += 256) {
    lb[e] = 0.f;
    float a = p.hgrn_lb[e], b = p.hgrn_lb[2048 + e];
    lb[2048 + e] = 1.f / (1.f + expf(a - b));
  }
  float* rt = (float*)(p.ws + OFF_ROPE);
  for (int e = tid; e < 64 * 32; e += 256) {
    int pos = e >> 5, i = e & 31;
    float inv = powf(10000.f, -(float)i / 32.f);
    float ang = (float)pos * inv;
    rt[2 * e] = cosf(ang);
    rt[2 * e + 1] = sinf(ang);
  }
}

DI int win_src_col(int n, int& la_d, int& la_c) {
  if (n < 4096) {
    int hh = n >> 11, j = n & 2047;
    if (j < 256) return hh * 256 + j;
    if (j < 512) return 512 + hh * 256 + (j - 256);
    if (j < 1024) return 1024 + hh * 512 + (j - 512);
    if (j < 1536) return 2048 + hh * 512 + (j - 1024);
    la_d = (j - 1536) >> 8;
    la_c = hh * 256 + ((j - 1536) & 255);
    return -1;
  }
  if (n < 9216) {
    int m = n - 4096;
    int hh = m / 2560, j = m % 2560;
    if (j < 512) return 3104 + hh * 512 + j;
    if (j < 1024) return 4128 + hh * 512 + (j - 512);
    if (j < 1536) return 5152 + hh * 512 + (j - 1024);
    if (j < 2048) return 6176 + hh * 512 + (j - 1536);
    return 7200 + hh * 512 + (j - 2048);
  }
  if (n < 11776) return 8224 + (n - 9216);
  return 10784 + (n - 11776);
}

DI void transpose_tile(const float* src, int ld_src, int k0, int c0, bf16_t* dst, int ld_dst, char* smem) {
  float(*tile)[65] = (float(*)[65])smem;
  const int tid = tid_();
#pragma unroll
  for (int i = 0; i < 4; ++i) {
    int kk = (tid >> 4) + 16 * i, c4 = (tid & 15) * 4;
    float4 v = *(const float4*)(src + (size_t)(k0 + kk) * ld_src + c0 + c4);
    tile[kk][c4] = v.x; tile[kk][c4 + 1] = v.y; tile[kk][c4 + 2] = v.z; tile[kk][c4 + 3] = v.w;
  }
  __syncthreads();
#pragma unroll
  for (int i = 0; i < 2; ++i) {
    int nn = (tid >> 3) + 32 * i, k8 = (tid & 7) * 8;
    uint4 o;
    o.x = pack2(tile[k8][nn], tile[k8 + 1][nn]);
    o.y = pack2(tile[k8 + 2][nn], tile[k8 + 3][nn]);
    o.z = pack2(tile[k8 + 4][nn], tile[k8 + 5][nn]);
    o.w = pack2(tile[k8 + 6][nn], tile[k8 + 7][nn]);
    *(uint4*)(dst + (size_t)nn * ld_dst + k0 + k8) = o;
  }
  __syncthreads();
}

constexpr int NW_ITEMS = 232 * 16 + 768 + 256;
DI void weight_item(const Params& p, int l, int item, char* smem) {
  const int tid = tid_();
  if (item < 232 * 16) {
    const int nt = item >> 4, kt = item & 15;
    const int n0 = nt * 64, k0 = kt * 64;
    int la_d = 0, la_c = 0;
    const int sc = win_src_col(n0, la_d, la_c);
    const float* win = p.w_in + (size_t)l * 1024 * NIN;
    bf16_t* dst = (bf16_t*)(p.ws + OFF_WINT) + (size_t)n0 * 1024;
    if (sc >= 0) {
      transpose_tile(win, NIN, k0, sc, dst, 1024, smem);
    } else {
      const int kk = tid & 63, nq = tid >> 6;
      const float* lrp = win + (size_t)(k0 + kk) * NIN + 3072 + la_d * 16;
      float lr[16];
#pragma unroll
      for (int r4 = 0; r4 < 4; ++r4) {
        float4 v = *(const float4*)(lrp + 4 * r4);
        lr[4 * r4] = v.x; lr[4 * r4 + 1] = v.y; lr[4 * r4 + 2] = v.z; lr[4 * r4 + 3] = v.w;
      }
      const float* a2 = p.gla_w_a2 + ((size_t)(l * 2 + la_d) * 16) * 512 + la_c + nq * 16;
#pragma unroll 1
      for (int nn = 0; nn < 16; ++nn) {
        float sacc = 0.f;
#pragma unroll
        for (int r = 0; r < 16; ++r) sacc += lr[r] * a2[(size_t)r * 512 + nn];
        dst[(size_t)(nq * 16 + nn) * 1024 + k0 + kk] = f2bf(sacc);
      }
    }
  } else if (item < 232 * 16 + 768) {
    int it = item - 232 * 16;
    const int n = it >> 8, dt = (it >> 4) & 15, kt = it & 15;
    const float* src = p.w_branch + ((size_t)(l * 3 + n)) * 1024 * 1024;
    bf16_t* dst = (bf16_t*)(p.ws + OFF_WBRT) + ((size_t)n * 1024 + dt * 64) * 1024;
    transpose_tile(src, 1024, kt * 64, dt * 64, dst, 1024, smem);
  } else {
    int it = item - 232 * 16 - 768;
    const int dt = it >> 4, kt = it & 15;
    const float* src = p.w_out + (size_t)l * 1024 * 1024;
    bf16_t* dst = (bf16_t*)(p.ws + OFF_WOUTT) + (size_t)(dt * 64) * 1024;
    transpose_tile(src, 1024, kt * 64, dt * 64, dst, 1024, smem);
  }
}

DI void h_item(const Params& p, int l, int item) {
  const int tid = tid_(), lane = tid & 63, w = tid >> 6;
  const float* ng = p.norm_g + l * 1024;
  bf16_t* H = (bf16_t*)(p.ws + OFF_H);
  for (int rr = 0; rr < 32; ++rr) {
    const int row = item * 128 + w * 32 + rr;
    const int b = row / SP, pos = row % SP;
    const float* src;
    int mr;
    if (pos < 256) {
      src = (l == 0 ? p.ctx : (const float*)(p.ws + OFF_CTX1)) + (size_t)(b * 256 + pos) * 1024;
      mr = 8;
    } else {
      src = (l == 0 ? p.x : (const float*)p.out) + (size_t)(b * 4096 + pos - 256) * 1024;
      mr = b;
    }
    const float* mod = (const float*)(p.ws + OFF_MOD) + ((size_t)(l * 9 + mr)) * 3072;
    float4 v[4];
    float ss = 0.f;
#pragma unroll
    for (int i = 0; i < 4; ++i) {
      v[i] = *(const float4*)(src + i * 256 + lane * 4);
      ss += v[i].x * v[i].x + v[i].y * v[i].y + v[i].z * v[i].z + v[i].w * v[i].w;
    }
#pragma unroll
    for (int o = 32; o >= 1; o >>= 1) ss += __shfl_xor(ss, o);
    const float rstd = rsqrtf(ss * (1.f / 1024.f) + EPSN);
#pragma unroll
    for (int i = 0; i < 4; ++i) {
      const int c = i * 256 + lane * 4;
      float4 g4 = *(const float4*)(ng + c);
      float4 sh = *(const float4*)(mod + c);
      float4 sc = *(const float4*)(mod + 1024 + c);
      float y0 = v[i].x * rstd * g4.x * (1.f + sc.x) + sh.x;
      float y1 = v[i].y * rstd * g4.y * (1.f + sc.y) + sh.y;
      float y2 = v[i].z * rstd * g4.z * (1.f + sc.z) + sh.z;
      float y3 = v[i].w * rstd * g4.w * (1.f + sc.w) + sh.w;
      *(uint2*)(H + (size_t)row * 1024 + c) = make_uint2(pack2(y0, y1), pack2(y2, y3));
    }
  }
}

typedef unsigned u32x4_t __attribute__((ext_vector_type(4)));
DI void gload16(u32x4_t& r, const void* sbase, unsigned voff) {
  asm volatile("global_load_dwordx4 %0, %1, %2" : "=v"(r) : "v"(voff), "s"(sbase) : "memory");
}
template <int NB>
DI void gemm_wait(u32x4_t (&ra)[4], u32x4_t (&rb)[NB]);
template <>
DI void gemm_wait<4>(u32x4_t (&ra)[4], u32x4_t (&rb)[4]) {
  asm volatile("s_waitcnt vmcnt(8)"
               : "+v"(ra[0]), "+v"(ra[1]), "+v"(ra[2]), "+v"(ra[3]), "+v"(rb[0]), "+v"(rb[1]), "+v"(rb[2]), "+v"(rb[3])
               :
               : "memory");
}
template <>
DI void gemm_wait<2>(u32x4_t (&ra)[4], u32x4_t (&rb)[2]) {
  asm volatile("s_waitcnt vmcnt(6)"
               : "+v"(ra[0]), "+v"(ra[1]), "+v"(ra[2]), "+v"(ra[3]), "+v"(rb[0]), "+v"(rb[1])
               :
               : "memory");
}
template <int NB>
DI void gemm_drain(u32x4_t (&ra)[4], u32x4_t (&rb)[NB]);
template <>
DI void gemm_drain<4>(u32x4_t (&ra)[4], u32x4_t (&rb)[4]) {
  asm volatile("s_waitcnt vmcnt(0)"
               : "+v"(ra[0]), "+v"(ra[1]), "+v"(ra[2]), "+v"(ra[3]), "+v"(rb[0]), "+v"(rb[1]), "+v"(rb[2]), "+v"(rb[3])
               :
               : "memory");
}
template <>
DI void gemm_drain<2>(u32x4_t (&ra)[4], u32x4_t (&rb)[2]) {
  asm volatile("s_waitcnt vmcnt(0)"
               : "+v"(ra[0]), "+v"(ra[1]), "+v"(ra[2]), "+v"(ra[3]), "+v"(rb[0]), "+v"(rb[1])
               :
               : "memory");
}

template <int NT>
DI void gemm512(f32x16 (&acc)[4][NT], const bf16_t* __restrict__ A, const bf16_t* __restrict__ Bt, int m0, int n0,
                char* smem) {
  typedef bf16_t(*tile_t)[256][72];
  tile_t As = (tile_t)smem;
  tile_t Bs = (tile_t)(smem + 73728);
  constexpr int NB = 2 * NT;
  const int tid = tid512_(), lane = tid & 63, w = tid >> 6, wm = w >> 2, wn = w & 3;
  const int l32 = lane & 31, h = lane >> 5;
  const int lr = tid >> 3, lc = (tid & 7) * 8;
  const unsigned voff = (unsigned)(lr * 1024 + lc) * 2u;
  const bf16_t* Ab = A + (size_t)m0 * 1024;
  const bf16_t* Bb = Bt + (size_t)n0 * 1024;
  u32x4_t xa[4], xb[NB];
#define GEMM_ISSUE(RA, RB, KT)                                                                     \
  {                                                                                                \
    const int kn_ = min((KT), 15) * 64;                                                            \
    _Pragma("unroll") for (int i = 0; i < 4; ++i) gload16(RA[i], Ab + (size_t)(64 * i) * 1024 + kn_, voff);  \
    _Pragma("unroll") for (int i = 0; i < NB; ++i) gload16(RB[i], Bb + (size_t)(64 * i) * 1024 + kn_, voff); \
  }
#define GEMM_STORE(RA, RB, BUF)                                                                    \
  {                                                                                                \
    _Pragma("unroll") for (int i = 0; i < 4; ++i) *(u32x4_t*)&As[BUF][lr + 64 * i][lc] = RA[i];   \
    _Pragma("unroll") for (int i = 0; i < NB; ++i) *(u32x4_t*)&Bs[BUF][lr + 64 * i][lc] = RB[i];  \
  }
#define GEMM_COMPUTE(BUF)                                                                                              \
  _Pragma("unroll") for (int ks = 0; ks < 4; ++ks) {                                                                   \
    bf16x8 af[4], bfr[NT];                                                                                             \
    _Pragma("unroll") for (int mt = 0; mt < 4; ++mt) af[mt] =                                                          \
        *(const bf16x8*)&As[BUF][128 * wm + 32 * mt + l32][16 * ks + 8 * h];                                          \
    _Pragma("unroll") for (int nt = 0; nt < NT; ++nt) bfr[nt] =                                                        \
        *(const bf16x8*)&Bs[BUF][32 * NT * wn + 32 * nt + l32][16 * ks + 8 * h];                                      \
    _Pragma("unroll") for (int mt = 0; mt < 4; ++mt) _Pragma("unroll") for (int nt = 0; nt < NT; ++nt) acc[mt][nt] =   \
        MFMA32(af[mt], bfr[nt], acc[mt][nt]);                                                                          \
  }
  GEMM_ISSUE(xa, xb, 0);
  gemm_drain<NB>(xa, xb);
  GEMM_STORE(xa, xb, 0);
  GEMM_ISSUE(xa, xb, 1);
  __syncthreads();
#pragma unroll 1
#define GEMM_FRAGS(BUF, KS, AF, BF)                                                                                    \
  {                                                                                                                    \
    _Pragma("unroll") for (int mt = 0; mt < 4; ++mt) AF[mt] =                                                          \
        *(const bf16x8*)&As[BUF][128 * wm + 32 * mt + l32][16 * (KS) + 8 * h];                                        \
    _Pragma("unroll") for (int nt = 0; nt < NT; ++nt) BF[nt] =                                                         \
        *(const bf16x8*)&Bs[BUF][32 * NT * wn + 32 * nt + l32][16 * (KS) + 8 * h];                                    \
  }
#define GEMM_MFMAS(AF, BF)                                                                                             \
  _Pragma("unroll") for (int mt = 0; mt < 4; ++mt) _Pragma("unroll") for (int nt = 0; nt < NT; ++nt) acc[mt][nt] =     \
      MFMA32(AF[mt], BF[nt], acc[mt][nt]);
#define GEMM_HALF(BUF, OTHER, KNEXT)                                                                                   \
  {                                                                                                                    \
    bf16x8 af0[4], bf0[NT];                                                                                            \
    GEMM_FRAGS(BUF, 0, af0, bf0);                                                                                      \
    bf16x8 af1[4], bf1[NT];                                                                                            \
    GEMM_FRAGS(BUF, 1, af1, bf1);                                                                                      \
    GEMM_MFMAS(af0, bf0);                                                                                              \
    gemm_drain<NB>(xa, xb);                                     \
    GEMM_STORE(xa, xb, OTHER);                                                                                         \
    GEMM_ISSUE(xa, xb, KNEXT);                                                                                         \
    GEMM_FRAGS(BUF, 2, af0, bf0);                                                                                      \
    GEMM_MFMAS(af1, bf1);                                                                                              \
    GEMM_FRAGS(BUF, 3, af1, bf1);                                                                                      \
    GEMM_MFMAS(af0, bf0);                                                                                              \
    GEMM_MFMAS(af1, bf1);                                                                                              \
  }
  for (int kt = 0; kt < 16; kt += 2) {
    GEMM_HALF(0, 1, kt + 2);
    __syncthreads();
    GEMM_HALF(1, 0, kt + 3);
    __syncthreads();
  }
#undef GEMM_FRAGS
#undef GEMM_MFMAS
#undef GEMM_HALF
  gemm_drain<NB>(xa, xb);
#undef GEMM_ISSUE
#undef GEMM_STORE
#undef GEMM_COMPUTE
}

template <int NT>
DI void zero_acc(f32x16 (&acc)[4][NT]) {
#pragma unroll
  for (int mt = 0; mt < 4; ++mt)
#pragma unroll
    for (int nt = 0; nt < NT; ++nt)
#pragma unroll
      for (int i = 0; i < 16; ++i) acc[mt][nt][i] = 0.f;
}

DI void inproj_tile(const Params& p, int l, int u, int mtile, int ntile, char* smem) {
  const int ubase = (u < 2) ? u * 2048 : (u < 4 ? 4096 + (u - 2) * 2560 : 9216);
  f32x16 acc[4][2];
  zero_acc<2>(acc);
  const int m0 = mtile * 256, n0 = ntile * 256;
  gemm512<2>(acc, (const bf16_t*)(p.ws + OFF_H), (const bf16_t*)(p.ws + OFF_WINT) + (size_t)ubase * 1024, m0, n0, smem);
  const int tid = tid512_(), lane = tid & 63, w = tid >> 6, wm = w >> 2, wn = w & 3;
  const int l32 = lane & 31, h = lane >> 5;
  const int b = m0 / SP;
  const int pos_w = (m0 % SP) + 128 * wm;
  const int row_w = m0 + 128 * wm;
  const int jb = n0 + 64 * wn;
  char* R = p.ws + OFF_R;
  bf16_t* stage = (bf16_t*)(smem + w * 18432);
  int kind, off;
  bf16_t* dbase;
  int ld = 0;
  if (u < 2) {
    if (jb < 1024) { kind = 0; off = 0; dbase = (bf16_t*)(R + R_TR) + (size_t)b * 1536 * SP; }
    else if (jb < 1536) { kind = 1; off = -1024; dbase = (bf16_t*)(R + R_RMG); ld = 512; }
    else { kind = 0; off = -512; dbase = (bf16_t*)(R + R_TR) + (size_t)b * 1536 * SP; }
  } else if (u < 4) {
    if (jb < 2048) { kind = 0; off = 0; dbase = (bf16_t*)(R + R_TR) + (size_t)b * 2048 * SP; }
    else { kind = 1; off = -2048; dbase = (bf16_t*)(R + R_RMG); ld = 512; }
  } else {
    if (jb < 1280) { kind = 1; off = 0; dbase = (bf16_t*)R; ld = 2304; }
    else if (jb < 1536) { kind = 0; off = -1280; dbase = (bf16_t*)(R + R_ATT_V) + (size_t)b * 256 * SP; }
    else { kind = 1; off = -256; dbase = (bf16_t*)R; ld = 2304; }
  }
  if (u == 4 && jb < 1280) {
    const float* rt = (const float*)(p.ws + OFF_ROPE);
    const float qs = (jb < 1024) ? 0.08838834764831845f : 1.f;
    const int half = (jb >> 6) & 1;
#pragma unroll
    for (int mt = 0; mt < 4; ++mt)
#pragma unroll
      for (int i = 0; i < 16; ++i) {
        const int rr = 32 * mt + 8 * (i >> 2) + 4 * h + (i & 3);
        const int pos = pos_w + rr;
        const float u1 = acc[mt][0][i], u2 = acc[mt][1][i];
        float o1 = u1, o2 = u2;
        if (pos >= 256) {
          const int t = pos - 256;
          const int pp = half ? (t & 63) : (t >> 6);
          const float2 cs = *(const float2*)(rt + (size_t)(pp * 32 + l32) * 2);
          o1 = u1 * cs.x - u2 * cs.y;
          o2 = u2 * cs.x + u1 * cs.y;
        }
        stage[rr * 72 + l32] = f2bf(o1 * qs);
        stage[rr * 72 + 32 + l32] = f2bf(o2 * qs);
      }
  } else {
#pragma unroll
    for (int nt = 0; nt < 2; ++nt) {
      const int j = jb + 32 * nt + l32;
      int mode = 0;
      float aux = 0.f;
      if (u < 2) {
        if (j < 256) mode = 1;
        else if (j >= 1536) { mode = 3; const int d = (j - 1536) >> 8, cc = (j - 1536) & 255;
                              aux = p.gla_b_a2[(size_t)(l * 2 + d) * 512 + u * 256 + cc]; }
      } else if (u < 4) {
        if (j >= 512 && j < 1536) { mode = 4; const int d = (j - 512) >> 9, cc = (j - 512) & 511;
                                    aux = ((const float*)(p.ws + OFF_LB))[(size_t)(l * 2 + d) * 1024 + (u - 2) * 512 + cc]; }
      }
#pragma unroll
      for (int mt = 0; mt < 4; ++mt)
#pragma unroll
        for (int q = 0; q < 4; ++q) {
          float v[4];
#pragma unroll
          for (int e = 0; e < 4; ++e) v[e] = acc[mt][nt][4 * q + e];
          if (mode == 1) {
#pragma unroll
            for (int e = 0; e < 4; ++e) v[e] *= 0.08838834764831845f;
          } else if (mode == 3) {
#pragma unroll
            for (int e = 0; e < 4; ++e) v[e] = logsigf_(v[e] + aux) * (1.f / 16.f);
          } else if (mode == 4) {
#pragma unroll
            for (int e = 0; e < 4; ++e) v[e] = (aux > 0.f) ? __logf(aux + (1.f - aux) * sigmoidf_(v[e])) : logsigf_(v[e]);
          }
          const int rr = 32 * mt + 8 * q + 4 * h;
          if (kind == 0) {
            *(uint2*)(stage + (32 * nt + l32) * 136 + rr) = make_uint2(pack2(v[0], v[1]), pack2(v[2], v[3]));
          } else {
            const unsigned p01 = pack2(v[0], v[1]), p23 = pack2(v[2], v[3]);
            bf16_t* sp = stage + rr * 72 + 32 * nt + l32;
            sp[0] = (bf16_t)(p01 & 0xffffu); sp[72] = (bf16_t)(p01 >> 16);
            sp[144] = (bf16_t)(p23 & 0xffffu); sp[216] = (bf16_t)(p23 >> 16);
          }
        }
    }
  }
  if (kind == 0) {
    bf16_t* dst = dbase + (size_t)(jb + off + (lane >> 4)) * SP + pos_w + 8 * (lane & 15);
    const bf16_t* src = stage + (lane >> 4) * 136 + 8 * (lane & 15);
#pragma unroll
    for (int i = 0; i < 16; ++i) *(uint4*)(dst + (size_t)(4 * i) * SP) = *(const uint4*)(src + 4 * i * 136);
  } else {
    bf16_t* dst = dbase + (size_t)(row_w + (lane >> 3)) * ld + jb + off + 8 * (lane & 7);
    const bf16_t* src = stage + (lane >> 3) * 72 + 8 * (lane & 7);
#pragma unroll
    for (int i = 0; i < 16; ++i) *(uint4*)(dst + (size_t)(8 * i) * ld) = *(const uint4*)(src + 8 * i * 72);
  }
  __syncthreads();
}

DI bf16x8 ld_perm(const bf16_t* rowp, int g) {
  uint2 a = *(const uint2*)(rowp + 4 * g);
  uint2 b = *(const uint2*)(rowp + 16 + 4 * g);
  uint4 r = make_uint4(a.x, a.y, b.x, b.y);
  return __builtin_bit_cast(bf16x8, r);
}
DI bf16x8 pack_acc2(const f32x4& a, const f32x4& b) {
  uint4 r = make_uint4(pack2(a[0], a[1]), pack2(a[2], a[3]), pack2(b[0], b[1]), pack2(b[2], b[3]));
  return __builtin_bit_cast(bf16x8, r);
}

struct ScanRaw { uint4 la0, la1, q0, q1, k0, k1, v; };

template <bool gla, int dir>
DI void scan_body(const Params& p, int hl, int vs, int b, char* smem) {
  constexpr int V = gla ? 256 : 128, ntr = gla ? 1536 : 2048;
  const int qcol = hl * 128;
  const int kcol = 256 + hl * 128;
  const int lacol = gla ? (1024 + dir * 256 + hl * 128) : (512 + dir * 512 + hl * 128);
  const int vcol = gla ? (512 + hl * 256 + vs * 64) : (1536 + hl * 128 + vs * 64);
  char* R = p.ws + OFF_R;
  const bf16_t* TRb = (const bf16_t*)(R + R_TR) + (size_t)b * ntr * SP;
  bf16_t* O = (bf16_t*)(R + R_O) + (size_t)dir * T * 512;

  constexpr int BUFB = 33280;
  const int tid = tid512_(), lane = tid & 63, w = tid >> 6, l16 = lane & 15, g = lane >> 4;
  const int vt = tid & 255;
  const int c = vt >> 1, th = vt & 1;
  const int pc = (c & ~31) | (8 * ((c & 15) >> 2) + (c & 3) + ((c & 16) ? 4 : 0));
  const int vn = vt >> 2, vpc = vt & 3;
  const bf16_t* la_g = TRb + (size_t)(lacol + c) * SP + 16 * th;
  const bf16_t* q_g = TRb + (size_t)(qcol + c) * SP + 16 * th;
  const bf16_t* k_g = TRb + (size_t)(kcol + c) * SP + 16 * th;
  const bf16_t* v_g = TRb + (size_t)(vcol + vn) * SP + 8 * vpc;
  bf16_t* Og = O + (size_t)(b * SP + 4 * g) * 512 + hl * V + vs * 64 + 16 * (w & 3) + l16;

  auto chunk_pos = [&](int ch) -> int {
    return (dir == 0) ? ch * 32 : (ch < 8 ? (7 - ch) * 32 : 256 + (135 - ch) * 32);
  };
  auto load_raw = [&](ScanRaw& r, int ch) {
    const int p0 = chunk_pos(ch);
    r.la0 = *(const uint4*)(la_g + p0);
    r.la1 = *(const uint4*)(la_g + p0 + 8);
    r.q0 = *(const uint4*)(q_g + p0);
    r.q1 = *(const uint4*)(q_g + p0 + 8);
    if (gla) {
      r.k0 = *(const uint4*)(k_g + p0);
      r.k1 = *(const uint4*)(k_g + p0 + 8);
    }
    r.v = *(const uint4*)(v_g + p0);
  };
  auto prep = [&](const ScanRaw& r, char* buf) {
    bf16_t(*Qd)[136] = (bf16_t(*)[136])buf;
    bf16_t(*Kd)[136] = (bf16_t(*)[136])(buf + 8704);
    bf16_t(*KdT)[40] = (bf16_t(*)[40])(buf + 17408);
    bf16_t(*VT)[40] = (bf16_t(*)[40])(buf + 27648);
    float* dec = (float*)(buf + 32768);
    {
      const int vp0 = 16 * (vpc & 1) + 4 * (vpc >> 1);
      *(uint2*)&VT[vn][vp0] = make_uint2(r.v.x, r.v.y);
      *(uint2*)&VT[vn][vp0 + 8] = make_uint2(r.v.z, r.v.w);
    }
    const unsigned lau[8] = {r.la0.x, r.la0.y, r.la0.z, r.la0.w, r.la1.x, r.la1.y, r.la1.z, r.la1.w};
    const unsigned qu[8] = {r.q0.x, r.q0.y, r.q0.z, r.q0.w, r.q1.x, r.q1.y, r.q1.z, r.q1.w};
    const unsigned ku[8] = {r.k0.x, r.k0.y, r.k0.z, r.k0.w, r.k1.x, r.k1.y, r.k1.z, r.k1.w};
    float f[16], ea[16], eb[16];
#pragma unroll
    for (int i = 0; i < 8; ++i) { f[2 * i] = __expf(bflo(lau[i])); f[2 * i + 1] = __expf(bfhi(lau[i])); }
    float own = 1.f;
    if (dir == 0) {
      float run = 1.f;
#pragma unroll
      for (int i = 0; i < 16; ++i) { run *= f[i]; ea[i] = run; }
      own = run;
      run = 1.f;
#pragma unroll
      for (int i = 15; i >= 0; --i) { eb[i] = run; run *= f[i]; }
    } else {
      float run = 1.f;
#pragma unroll
      for (int i = 15; i >= 0; --i) { run *= f[i]; ea[i] = run; }
      own = run;
      run = 1.f;
#pragma unroll
      for (int i = 0; i < 16; ++i) { eb[i] = run; run *= f[i]; }
    }
    const float other = __shfl_xor(own, 1);
    const float total = own * other;
    const float mula = (dir == 0) ? (th == 1 ? other : 1.f) : (th == 0 ? other : 1.f);
    const float mulb = ((dir == 0) ? (th == 0 ? other : 1.f) : (th == 1 ? other : 1.f)) *
                       __builtin_amdgcn_rcpf(fmaxf(total, 1e-35f));
    if (th == 0) dec[c] = total;
    unsigned kdp[8];
#pragma unroll
    for (int i = 0; i < 8; ++i) {
      float kd2[2], qd2[2];
#pragma unroll
      for (int h2 = 0; h2 < 2; ++h2) {
        const int ii = 2 * i + h2;
        const float qv = (h2 ? bfhi(qu[i]) : bflo(qu[i])) * mula;
        float kv;
        if (gla) kv = (h2 ? bfhi(ku[i]) : bflo(ku[i])) * mulb;
        else kv = mulb - mulb * f[ii];
        qd2[h2] = qv * ea[ii];
        kd2[h2] = kv * eb[ii];
      }
      const unsigned qdp = pack2(qd2[0], qd2[1]);
      kdp[i] = pack2(kd2[0], kd2[1]);
      Qd[16 * th + 2 * i][pc] = (bf16_t)(qdp & 0xffffu);
      Qd[16 * th + 2 * i + 1][pc] = (bf16_t)(qdp >> 16);
      Kd[16 * th + 2 * i][pc] = (bf16_t)(kdp[i] & 0xffffu);
      Kd[16 * th + 2 * i + 1][pc] = (bf16_t)(kdp[i] >> 16);
    }
#pragma unroll
    for (int k4 = 0; k4 < 4; ++k4) *(uint2*)&KdT[c][8 * k4 + 4 * th] = make_uint2(kdp[2 * k4], kdp[2 * k4 + 1]);
  };

  f32x4 S[8];
#pragma unroll
  for (int i = 0; i < 8; ++i) S[i] = (f32x4){0.f, 0.f, 0.f, 0.f};

  auto mload = [&](const char* buf, bf16x8 (&Qf)[2][4], bf16x8 (&Kf)[2][4], bf16x8& Vf) {
    const bf16_t(*Qd)[136] = (const bf16_t(*)[136])buf;
    const bf16_t(*Kd)[136] = (const bf16_t(*)[136])(buf + 8704);
    const bf16_t(*VT)[40] = (const bf16_t(*)[40])(buf + 27648);
#pragma unroll
    for (int it = 0; it < 2; ++it)
#pragma unroll
      for (int ks = 0; ks < 4; ++ks) {
        Qf[it][ks] = *(const bf16x8*)&Qd[16 * it + l16][32 * ks + 8 * g];
        Kf[it][ks] = *(const bf16x8*)&Kd[16 * it + l16][32 * ks + 8 * g];
      }
    Vf = *(const bf16x8*)&VT[16 * (w & 3) + l16][8 * g];
  };
  auto matrix = [&](const char* buf, int p0, const bf16x8 (&Qf)[2][4], const bf16x8 (&Kf)[2][4], const bf16x8& Vf) {
    const bf16_t(*KdT)[40] = (const bf16_t(*)[40])(buf + 17408);
    const float* dec = (const float*)(buf + 32768);
    bf16x8 Sb[4];
#pragma unroll
    for (int ks = 0; ks < 4; ++ks) Sb[ks] = pack_acc2(S[2 * ks], S[2 * ks + 1]);
    f32x4 Oa[2];
    f32x4 att[2][2];
#pragma unroll
    for (int it = 0; it < 2; ++it) {
      Oa[it] = (f32x4){0.f, 0.f, 0.f, 0.f};
#pragma unroll
      for (int ks = 0; ks < 4; ++ks) Oa[it] = MFMA16(Qf[it][ks], Sb[ks], Oa[it]);
    }
#pragma unroll
    for (int jt = 0; jt < 2; ++jt) {
      att[jt][0] = (f32x4){0.f, 0.f, 0.f, 0.f};
      att[jt][1] = (f32x4){0.f, 0.f, 0.f, 0.f};
#pragma unroll
      for (int ks = 0; ks < 4; ++ks) {
        att[jt][0] = MFMA16(Kf[jt][ks], Qf[0][ks], att[jt][0]);
        att[jt][1] = MFMA16(Kf[jt][ks], Qf[1][ks], att[jt][1]);
      }
    }
    bf16x8 KTf[8];
    f32x4 dcv[8];
#pragma unroll
    for (int kt = 0; kt < 8; ++kt) {
      KTf[kt] = *(const bf16x8*)&KdT[16 * kt + l16][8 * g];
      dcv[kt] = *(const f32x4*)&dec[16 * kt + 4 * g];
    }
#pragma unroll
    for (int jt = 0; jt < 2; ++jt)
#pragma unroll
      for (int it = 0; it < 2; ++it)
#pragma unroll
        for (int r = 0; r < 4; ++r) {
          const int j = 16 * jt + 4 * g + r, i = 16 * it + l16;
          const bool keep = (dir == 0) ? (j <= i) : (j >= i);
          att[jt][it][r] = keep ? att[jt][it][r] : 0.f;
        }
#pragma unroll
    for (int it = 0; it < 2; ++it) {
      bf16x8 Pf = pack_acc2(att[0][it], att[1][it]);
      Oa[it] = MFMA16(Pf, Vf, Oa[it]);
    }
    {
      bf16_t* Op = Og + (size_t)p0 * 512;
#pragma unroll
      for (int it = 0; it < 2; ++it)
#pragma unroll
        for (int r = 0; r < 4; ++r) Op[(size_t)(16 * it + r) * 512] = f2bf(Oa[it][r]);
    }
#pragma unroll
    for (int kt = 0; kt < 8; ++kt) {
      f32x4 up = MFMA16(KTf[kt], Vf, S[kt]);
      S[kt] = up * dcv[kt];
    }
  };

  const bool producer = w >= 4;
  ScanRaw ra, rb;
  ra.k0 = ra.k1 = rb.k0 = rb.k1 = make_uint4(0u, 0u, 0u, 0u);
  if (producer) {
    load_raw(ra, 0);
    load_raw(rb, 1);
    prep(ra, smem);
  }
  __syncthreads();
#pragma unroll 1
  for (int ch = 0; ch < 136; ch += 2) {
    if (producer) {
      load_raw(ra, min(ch + 2, 135));
      prep(rb, smem + BUFB);
    } else {
      bf16x8 Qf[2][4], Kf[2][4], Vf;
      mload(smem, Qf, Kf, Vf);
      matrix(smem, chunk_pos(ch), Qf, Kf, Vf);
    }
    __syncthreads();
    if (producer) {
      load_raw(rb, min(ch + 3, 135));
      prep(ra, smem);
    } else {
      bf16x8 Qf[2][4], Kf[2][4], Vf;
      mload(smem + BUFB, Qf, Kf, Vf);
      matrix(smem + BUFB, chunk_pos(ch + 1), Qf, Kf, Vf);
    }
    __syncthreads();
  }
}

DI void scan_item(const Params& p, int u, int item, char* smem) {
  const bool gla = u < 2;
  const int nh = gla ? 2 : 4, nvs = gla ? 4 : 2;
  const int vs = item % nvs;
  const int dir = (item / nvs) & 1;
  const int hl = (item / (2 * nvs)) % nh;
  const int b = item / (2 * nvs * nh);
  if (gla) {
    if (dir == 0) scan_body<true, 0>(p, hl, vs, b, smem);
    else scan_body<true, 1>(p, hl, vs, b, smem);
  } else {
    if (dir == 0) scan_body<false, 0>(p, hl, vs, b, smem);
    else scan_body<false, 1>(p, hl, vs, b, smem);
  }
}

DI void norm_rows(const Params& p, int l, int u, int row0, int nrows) {
  const bool gla = u < 2;
  const int hh = gla ? u : u - 2;
  const int V = gla ? 256 : 128;
  const int tid = tid_(), lane = tid & 63, w = tid >> 6;
  char* R = p.ws + OFF_R;
  const bf16_t* O0 = (const bf16_t*)(R + R_O);
  const bf16_t* O1 = O0 + (size_t)T * 512;
  const bf16_t* G = (const bf16_t*)(R + R_RMG);
  bf16_t* Y = (bf16_t*)(p.ws + (gla ? OFF_YGLA : OFF_YHG));
  const float* gain = (gla ? p.gla_norm_g + l * 256 : p.hgrn_norm_g + l * 128) + ((lane * 8) & (V - 1));
  float gn[8];
#pragma unroll
  for (int j = 0; j < 8; ++j) gn[j] = gain[j];
  for (int rr = w; rr < nrows; rr += 4) {
    const int row = row0 + rr;
    uint4 a = *(const uint4*)(O0 + (size_t)row * 512 + lane * 8);
    uint4 bq = *(const uint4*)(O1 + (size_t)row * 512 + lane * 8);
    uint4 gq = *(const uint4*)(G + (size_t)row * 512 + lane * 8);
    const unsigned au[4] = {a.x, a.y, a.z, a.w}, bu[4] = {bq.x, bq.y, bq.z, bq.w}, gu[4] = {gq.x, gq.y, gq.z, gq.w};
    float o[8], gt[8];
    float ss = 0.f;
#pragma unroll
    for (int i = 0; i < 4; ++i) {
      o[2 * i] = bflo(au[i]) + bflo(bu[i]);
      o[2 * i + 1] = bfhi(au[i]) + bfhi(bu[i]);
      gt[2 * i] = bflo(gu[i]);
      gt[2 * i + 1] = bfhi(gu[i]);
      ss += o[2 * i] * o[2 * i] + o[2 * i + 1] * o[2 * i + 1];
    }
    ss += __shfl_xor(ss, 1);
    ss += __shfl_xor(ss, 2);
    ss += __shfl_xor(ss, 4);
    ss += __shfl_xor(ss, 8);
    if (gla) ss += __shfl_xor(ss, 16);
    const float rstd = rsqrtf(ss / (float)V + EPSN);
    float y[8];
#pragma unroll
    for (int j = 0; j < 8; ++j) y[j] = o[j] * rstd * gn[j] * siluf_(gt[j]);
    *(uint4*)(Y + (size_t)row * 1024 + hh * 512 + lane * 8) =
        make_uint4(pack2(y[0], y[1]), pack2(y[2], y[3]), pack2(y[4], y[5]), pack2(y[6], y[7]));
  }
}

DI void attn_item(const Params& p, int l, int item, char* smem) {
  int b, qb, hk;
  bool isctx;
  if (item < 2048) { isctx = false; hk = item & 1; qb = (item >> 1) & 127; b = item >> 8; }
  else { int it = item - 2048; isctx = true; hk = it & 1; qb = (it >> 1) & 7; b = it >> 4; }
  char* R = p.ws + OFF_R;
  const bf16_t* RM = (const bf16_t*)R;
  const bf16_t* VTg = (const bf16_t*)(R + R_ATT_V) + (size_t)(b * 256 + hk * 128) * SP;
  bf16_t* Y = (bf16_t*)(R + R_O);
  constexpr int ABUF = 18944;
  const int tid = tid_(), lane = tid & 63, w = tid >> 6, l16 = lane & 15, g = lane >> 4;
  const int hq = hk * 4 + w;
  const int qpos0 = isctx ? qb * 32 : 256 + qb * 32;
  const int rowq0 = b * SP + qpos0;
  bf16x8 Qf[2][4];
#pragma unroll
  for (int qt = 0; qt < 2; ++qt)
#pragma unroll
    for (int ks = 0; ks < 4; ++ks)
      Qf[qt][ks] = *(const bf16x8*)(RM + (size_t)(rowq0 + 16 * qt + l16) * 2304 + hq * 128 + 32 * ks + 8 * g);
  float m[2], ls[2];
  const float sink = p.attn_sink[l * 8 + hq];
  m[0] = m[1] = sink;
  ls[0] = ls[1] = (g == 0) ? 1.f : 0.f;
  f32x4 Oa[8][2];
#pragma unroll
  for (int dt = 0; dt < 8; ++dt) { Oa[dt][0] = (f32x4){0.f, 0.f, 0.f, 0.f}; Oa[dt][1] = (f32x4){0.f, 0.f, 0.f, 0.f}; }
  const int bt_lo = isctx ? 1 : max(0, 4 - qb), bt_hi = isctx ? 0 : min(8, 131 - qb);
  const int ntiles = 8 + max(0, bt_hi - bt_lo + 1);
  const int kr = tid >> 4, kd8 = (tid & 15) * 8;
  const int vd = tid >> 2, vpc = tid & 3;
  const int vp0 = 16 * (vpc & 1) + 4 * (vpc >> 1);
  const bf16_t* Kg = RM + (size_t)(b * SP + kr) * 2304 + 1024 + hk * 128 + kd8;
  const bf16_t* Vg = VTg + (size_t)vd * SP + 8 * vpc;
  uint4 rk0, rk1, rv0, rv1;
#define ATT_TLOAD(TI)                                                                              \
  {                                                                                                \
    const int ti_ = (TI);                                                                          \
    const int kpos0_ = ti_ < 8 ? 32 * ti_ : 256 + qb * 32 - 128 + 32 * (bt_lo + ti_ - 8);          \
    rk0 = *(const uint4*)(Kg + (size_t)kpos0_ * 2304);                                             \
    rk1 = *(const uint4*)(Kg + (size_t)(kpos0_ + 16) * 2304);                                      \
    rv0 = *(const uint4*)(Vg + kpos0_);                                                            \
    rv1 = *(const uint4*)(Vg + (size_t)64 * SP + kpos0_);                                          \
  }
#define ATT_TSTORE(BUF)                                                                            \
  {                                                                                                \
    bf16_t(*Ks_)[136] = (bf16_t(*)[136])(BUF);                                                     \
    bf16_t(*VT_)[40] = (bf16_t(*)[40])((BUF) + 8704);                                              \
    *(uint4*)&Ks_[kr][kd8] = rk0;                                                                  \
    *(uint4*)&Ks_[kr + 16][kd8] = rk1;                                                             \
    *(uint2*)&VT_[vd][vp0] = make_uint2(rv0.x, rv0.y);                                             \
    *(uint2*)&VT_[vd][vp0 + 8] = make_uint2(rv0.z, rv0.w);                                         \
    *(uint2*)&VT_[vd + 64][vp0] = make_uint2(rv1.x, rv1.y);                                        \
    *(uint2*)&VT_[vd + 64][vp0 + 8] = make_uint2(rv1.z, rv1.w);                                    \
  }
  ATT_TLOAD(0);
  ATT_TSTORE(smem);
  ATT_TLOAD(min(1, ntiles - 1));
  __syncthreads();
#pragma unroll 1
  for (int ti = 0; ti < ntiles; ++ti) {
    char* buf = smem + (ti & 1) * ABUF;
    if (ti + 1 < ntiles) ATT_TSTORE(smem + ((ti + 1) & 1) * ABUF);
    ATT_TLOAD(min(ti + 2, ntiles - 1));
    int mtype = 0, tk0 = 0;
    if (ti >= 8) {
      const int bt = bt_lo + ti - 8;
      tk0 = qb * 32 - 128 + 32 * bt;
      mtype = (bt == 0) ? 1 : (bt == 8 ? 2 : 0);
    }
    const bf16_t(*Ks)[136] = (const bf16_t(*)[136])buf;
    const bf16_t(*VT)[40] = (const bf16_t(*)[40])(buf + 8704);
    bf16x8 Kf[2][4];
#pragma unroll
    for (int kt = 0; kt < 2; ++kt)
#pragma unroll
      for (int ks = 0; ks < 4; ++ks) Kf[kt][ks] = *(const bf16x8*)&Ks[16 * kt + l16][32 * ks + 8 * g];
    f32x4 st[2][2];
#pragma unroll
    for (int kt = 0; kt < 2; ++kt) { st[kt][0] = (f32x4){0.f, 0.f, 0.f, 0.f}; st[kt][1] = (f32x4){0.f, 0.f, 0.f, 0.f}; }
#pragma unroll
    for (int ks = 0; ks < 4; ++ks)
#pragma unroll
      for (int kt = 0; kt < 2; ++kt) {
        st[kt][0] = MFMA16(Kf[kt][ks], Qf[0][ks], st[kt][0]);
        st[kt][1] = MFMA16(Kf[kt][ks], Qf[1][ks], st[kt][1]);
      }
    bf16x8 Vf[8];
#pragma unroll
    for (int dt = 0; dt < 8; ++dt) Vf[dt] = *(const bf16x8*)&VT[16 * dt + l16][8 * g];
    if (mtype != 0) {
#pragma unroll
      for (int kt = 0; kt < 2; ++kt)
#pragma unroll
        for (int qt = 0; qt < 2; ++qt)
#pragma unroll
          for (int r = 0; r < 4; ++r) {
            const int tk = tk0 + 16 * kt + 4 * g + r, tq = qb * 32 + 16 * qt + l16;
            const bool keep = (mtype == 1) ? (tk >= tq - 128) : (tk <= tq + 128);
            st[kt][qt][r] = keep ? st[kt][qt][r] : -1e30f;
          }
    }
    bf16x8 Pf[2];
#pragma unroll
    for (int qt = 0; qt < 2; ++qt) {
      float tm = fmaxf(fmaxf(fmaxf(st[0][qt][0], st[0][qt][1]), fmaxf(st[0][qt][2], st[0][qt][3])),
                       fmaxf(fmaxf(st[1][qt][0], st[1][qt][1]), fmaxf(st[1][qt][2], st[1][qt][3])));
      tm = fmaxf(tm, __shfl_xor(tm, 16));
      tm = fmaxf(tm, __shfl_xor(tm, 32));
      const float mn = fmaxf(m[qt], tm);
      const float alpha = __expf(m[qt] - mn);
      m[qt] = mn;
      float ps = 0.f;
#pragma unroll
      for (int kt = 0; kt < 2; ++kt)
#pragma unroll
        for (int r = 0; r < 4; ++r) { float pv = __expf(st[kt][qt][r] - mn); st[kt][qt][r] = pv; ps += pv; }
      ls[qt] = ls[qt] * alpha + ps;
#pragma unroll
      for (int dt = 0; dt < 8; ++dt) Oa[dt][qt] *= alpha;
      Pf[qt] = pack_acc2(st[0][qt], st[1][qt]);
    }
#pragma unroll
    for (int dt = 0; dt < 8; ++dt) {
      Oa[dt][0] = MFMA16(Vf[dt], Pf[0], Oa[dt][0]);
      Oa[dt][1] = MFMA16(Vf[dt], Pf[1], Oa[dt][1]);
    }
    __syncthreads();
  }
#undef ATT_TLOAD
#undef ATT_TSTORE
#pragma unroll
  for (int qt = 0; qt < 2; ++qt) {
    float lt = ls[qt];
    lt += __shfl_xor(lt, 16);
    lt += __shfl_xor(lt, 32);
    const float inv = __builtin_amdgcn_rcpf(lt);
    const size_t row = (size_t)(rowq0 + 16 * qt + l16);
#pragma unroll
    for (int dt = 0; dt < 8; ++dt) {
      const int d = 16 * dt + 4 * g;
      uint2 gq = *(const uint2*)(RM + row * 2304 + 1280 + hq * 128 + d);
      float y0 = Oa[dt][qt][0] * inv * siluf_(bflo(gq.x));
      float y1 = Oa[dt][qt][1] * inv * siluf_(bfhi(gq.x));
      float y2 = Oa[dt][qt][2] * inv * siluf_(bflo(gq.y));
      float y3 = Oa[dt][qt][3] * inv * siluf_(bfhi(gq.y));
      *(uint2*)(Y + row * 1024 + hq * 128 + d) = make_uint2(pack2(y0, y1), pack2(y2, y3));
    }
  }
  __syncthreads();
}

DI void gemm_mainloop(f32x16 (&acc)[2][2], const bf16_t* __restrict__ A, int lda, const bf16_t* __restrict__ Bt,
                      int ldb, int K, int m0, int n0, char* smem) {
  typedef bf16_t(*tile_t)[128][72];
  tile_t As = (tile_t)smem;
  tile_t Bs = (tile_t)(smem + 2 * 128 * 72 * 2);
  const int tid = tid_(), lane = tid & 63, w = tid >> 6, wm = w >> 1, wn = w & 1;
  const int l32 = lane & 31, h = lane >> 5;
  const int lr = tid >> 3, lc = (tid & 7) * 8;
  const unsigned voa = (unsigned)(lr * lda + lc) * 2u, vob = (unsigned)(lr * ldb + lc) * 2u;
  const bf16_t* Ab = A + (size_t)m0 * lda;
  const bf16_t* Bb = Bt + (size_t)n0 * ldb;
  const int nk = K >> 6;
  u32x4_t xa[4], xb[4];
#define GEMM_ISSUE(RA, RB, KT)                                                     \
  {                                                                                \
    const int kn_ = min((KT), nk - 1) * 64;                                        \
    _Pragma("unroll") for (int i = 0; i < 4; ++i) {                                \
      gload16(RA[i], Ab + (size_t)(32 * i) * lda + kn_, voa);                      \
      gload16(RB[i], Bb + (size_t)(32 * i) * ldb + kn_, vob);                      \
    }                                                                              \
  }
#define GEMM_WAIT(N, RA, RB)                                                                                   \
  asm volatile("s_waitcnt vmcnt(" #N ")"                                                                       \
               : "+v"(RA[0]), "+v"(RA[1]), "+v"(RA[2]), "+v"(RA[3]), "+v"(RB[0]), "+v"(RB[1]), "+v"(RB[2]), \
                 "+v"(RB[3])                                                                                   \
               :                                                                                               \
               : "memory")
#define GEMM_STORE(RA, RB, BUF)                                                    \
  _Pragma("unroll") for (int i = 0; i < 4; ++i) {                                  \
    *(u32x4_t*)&As[BUF][lr + 32 * i][lc] = RA[i];                                  \
    *(u32x4_t*)&Bs[BUF][lr + 32 * i][lc] = RB[i];                                  \
  }
#define GEMM_COMPUTE(BUF)                                                                                              \
  _Pragma("unroll") for (int ks = 0; ks < 4; ++ks) {                                                                   \
    bf16x8 af[2], bfr[2];                                                                                              \
    _Pragma("unroll") for (int mt = 0; mt < 2; ++mt) af[mt] =                                                          \
        *(const bf16x8*)&As[BUF][64 * wm + 32 * mt + l32][16 * ks + 8 * h];                                           \
    _Pragma("unroll") for (int nt = 0; nt < 2; ++nt) bfr[nt] =                                                         \
        *(const bf16x8*)&Bs[BUF][64 * wn + 32 * nt + l32][16 * ks + 8 * h];                                           \
    _Pragma("unroll") for (int mt = 0; mt < 2; ++mt) _Pragma("unroll") for (int nt = 0; nt < 2; ++nt) acc[mt][nt] =    \
        MFMA32(af[mt], bfr[nt], acc[mt][nt]);                                                                          \
  }
  GEMM_ISSUE(xa, xb, 0);
  GEMM_WAIT(0, xa, xb);
  GEMM_STORE(xa, xb, 0);
  GEMM_ISSUE(xa, xb, 1);
  __syncthreads();
#pragma unroll 1
#define GEMM_FRAGS2(BUF, KS, AF, BF)                                                                                   \
  {                                                                                                                    \
    _Pragma("unroll") for (int mt = 0; mt < 2; ++mt) AF[mt] =                                                          \
        *(const bf16x8*)&As[BUF][64 * wm + 32 * mt + l32][16 * (KS) + 8 * h];                                         \
    _Pragma("unroll") for (int nt = 0; nt < 2; ++nt) BF[nt] =                                                          \
        *(const bf16x8*)&Bs[BUF][64 * wn + 32 * nt + l32][16 * (KS) + 8 * h];                                         \
  }
#define GEMM_MFMAS2(AF, BF)                                                                                            \
  _Pragma("unroll") for (int mt = 0; mt < 2; ++mt) _Pragma("unroll") for (int nt = 0; nt < 2; ++nt) acc[mt][nt] =      \
      MFMA32(AF[mt], BF[nt], acc[mt][nt]);
#define GEMM_HALF2(BUF, OTHER, KNEXT)                                                                                  \
  {                                                                                                                    \
    bf16x8 af0[2], bf0[2], af1[2], bf1[2];                                                                             \
    GEMM_FRAGS2(BUF, 0, af0, bf0);                                                                                     \
    GEMM_FRAGS2(BUF, 1, af1, bf1);                                                                                     \
    GEMM_MFMAS2(af0, bf0);                                                                                             \
    GEMM_WAIT(0, xa, xb);                                       \
    GEMM_STORE(xa, xb, OTHER);                                                                                         \
    GEMM_ISSUE(xa, xb, KNEXT);                                                                                         \
    GEMM_FRAGS2(BUF, 2, af0, bf0);                                                                                     \
    GEMM_MFMAS2(af1, bf1);                                                                                             \
    GEMM_FRAGS2(BUF, 3, af1, bf1);                                                                                     \
    GEMM_MFMAS2(af0, bf0);                                                                                             \
    GEMM_MFMAS2(af1, bf1);                                                                                             \
  }
  for (int kt = 0; kt < nk; kt += 2) {
    GEMM_HALF2(0, 1, kt + 2);
    __syncthreads();
    GEMM_HALF2(1, 0, kt + 3);
    __syncthreads();
  }
#undef GEMM_FRAGS2
#undef GEMM_MFMAS2
#undef GEMM_HALF2
  GEMM_WAIT(0, xa, xb);
#undef GEMM_ISSUE
#undef GEMM_WAIT
#undef GEMM_STORE
#undef GEMM_COMPUTE
}

DI void zero_acc22(f32x16 (&acc)[2][2]) {
#pragma unroll
  for (int mt = 0; mt < 2; ++mt)
#pragma unroll
    for (int nt = 0; nt < 2; ++nt)
#pragma unroll
      for (int i = 0; i < 16; ++i) acc[mt][nt][i] = 0.f;
}

DI void inproj_tile_small(const Params& p, int l, int u, int mtile, int ntile, char* smem) {
  const int ubase = (u < 2) ? u * 2048 : (u < 4 ? 4096 + (u - 2) * 2560 : 9216);
  f32x16 acc[2][2];
  zero_acc22(acc);
  const int m0 = mtile * 128, n0 = ntile * 128;
  gemm_mainloop(acc, (const bf16_t*)(p.ws + OFF_H), 1024, (const bf16_t*)(p.ws + OFF_WINT) + (size_t)ubase * 1024, 1024,
                1024, m0, n0, smem);
  const int tid = tid_(), lane = tid & 63, w = tid >> 6, wm = w >> 1, wn = w & 1;
  const int l32 = lane & 31, h = lane >> 5;
  const int b = m0 / SP;
  const int posb = (m0 % SP) + 64 * wm + 4 * h;
  const int rowb = m0 + 64 * wm + 4 * h;
  const int jb = n0 + 64 * wn;
  char* R = p.ws + OFF_R;
  if (u < 4) {
    const bool gla = u < 2;
    const int hh = gla ? u : u - 2;
    const int ntr = gla ? 1536 : 2048;
    bf16_t* TR = (bf16_t*)(R + R_TR) + (size_t)b * ntr * SP;
    bf16_t* RMG = (bf16_t*)(R + R_RMG);
#pragma unroll
    for (int nt = 0; nt < 2; ++nt) {
      const int j = jb + 32 * nt + l32;
      int mode, tcol = 0;
      float aux = 0.f;
      if (gla) {
        if (j < 256) { mode = 1; tcol = j; }
        else if (j < 1024) { mode = 0; tcol = j; }
        else if (j < 1536) { mode = 2; tcol = j - 1024; }
        else { mode = 3; tcol = j - 512; int d = (j - 1536) >> 8, cc = (j - 1536) & 255;
               aux = p.gla_b_a2[(size_t)(l * 2 + d) * 512 + hh * 256 + cc]; }
      } else {
        if (j < 512) { mode = 0; tcol = j; }
        else if (j < 1536) { mode = 4; tcol = j; int d = (j - 512) >> 9, cc = (j - 512) & 511;
                             aux = ((const float*)(p.ws + OFF_LB))[(size_t)(l * 2 + d) * 1024 + hh * 512 + cc]; }
        else if (j < 2048) { mode = 0; tcol = j; }
        else { mode = 2; tcol = j - 2048; }
      }
#pragma unroll
      for (int mt = 0; mt < 2; ++mt)
#pragma unroll
        for (int q = 0; q < 4; ++q) {
          float v[4];
#pragma unroll
          for (int e = 0; e < 4; ++e) v[e] = acc[mt][nt][4 * q + e];
          if (mode == 1) {
#pragma unroll
            for (int e = 0; e < 4; ++e) v[e] *= 0.08838834764831845f;
          } else if (mode == 3) {
#pragma unroll
            for (int e = 0; e < 4; ++e) v[e] = logsigf_(v[e] + aux) * (1.f / 16.f);
          } else if (mode == 4) {
#pragma unroll
            for (int e = 0; e < 4; ++e) {
              v[e] = (aux > 0.f) ? __logf(aux + (1.f - aux) * sigmoidf_(v[e])) : logsigf_(v[e]);
            }
          }
          if (mode == 2) {
#pragma unroll
            for (int e = 0; e < 4; ++e) RMG[(size_t)(rowb + 32 * mt + 8 * q + e) * 512 + tcol] = f2bf(v[e]);
          } else {
            *(uint2*)(TR + (size_t)tcol * SP + posb + 32 * mt + 8 * q) = make_uint2(pack2(v[0], v[1]), pack2(v[2], v[3]));
          }
        }
    }
  } else {
    bf16_t* RM = (bf16_t*)R;
    bf16_t* VT = (bf16_t*)(R + R_ATT_V) + (size_t)b * 256 * SP;
    const float* rt = (const float*)(p.ws + OFF_ROPE);
    if (jb < 1280) {
      const float qs = (jb < 1024) ? 0.08838834764831845f : 1.f;
      const int half = (jb >> 6) & 1;
#pragma unroll
      for (int mt = 0; mt < 2; ++mt)
#pragma unroll
        for (int i = 0; i < 16; ++i) {
          const int rr = 32 * mt + 8 * (i >> 2) + (i & 3);
          const int pos = posb + rr;
          const float u1 = acc[mt][0][i], u2 = acc[mt][1][i];
          float o1 = u1, o2 = u2;
          if (pos >= 256) {
            const int t = pos - 256;
            const int pp = half ? (t & 63) : (t >> 6);
            const float2 cs = *(const float2*)(rt + (size_t)(pp * 32 + l32) * 2);
            o1 = u1 * cs.x - u2 * cs.y;
            o2 = u2 * cs.x + u1 * cs.y;
          }
          bf16_t* dst = RM + (size_t)(rowb + rr) * 2304 + jb + l32;
          dst[0] = f2bf(o1 * qs);
          dst[32] = f2bf(o2 * qs);
        }
    } else {
#pragma unroll
      for (int nt = 0; nt < 2; ++nt) {
        const int j = jb + 32 * nt + l32;
#pragma unroll
        for (int mt = 0; mt < 2; ++mt)
#pragma unroll
          for (int q = 0; q < 4; ++q) {
            if (j < 1536) {
              *(uint2*)(VT + (size_t)(j - 1280) * SP + posb + 32 * mt + 8 * q) =
                  make_uint2(pack2(acc[mt][nt][4 * q], acc[mt][nt][4 * q + 1]), pack2(acc[mt][nt][4 * q + 2], acc[mt][nt][4 * q + 3]));
            } else {
#pragma unroll
              for (int e = 0; e < 4; ++e)
                RM[(size_t)(rowb + 32 * mt + 8 * q + e) * 2304 + (j - 256)] = f2bf(acc[mt][nt][4 * q + e]);
            }
          }
      }
    }
  }
}

DI void merge_tile(const Params& p, int mtile, int ntile, char* smem) {
  const int m0 = mtile * 128, n0 = ntile * 128;
  const int tid = tid_(), lane = tid & 63, w = tid >> 6, wm = w >> 1, wn = w & 1, l32 = lane & 31, h = lane >> 5;
  float4* const park0 = (float4*)(p.ws + OFF_R + SZ_ACT) + (size_t)blockIdx.x * (48 * 512) + (size_t)(threadIdx.x >> 8) * 6144 + tid;
#pragma unroll 1
  for (int pass = 0; pass < 6; ++pass) {
    const int n = pass >> 1, kind = pass & 1;
    const bf16_t* A;
    const bf16_t* B;
    if (kind == 0) {
      A = (const bf16_t*)(p.ws + OFF_H);
      B = (const bf16_t*)(p.ws + OFF_WINT) + (size_t)(11776 + n * 1024) * 1024;
    } else {
      A = (n == 0) ? (const bf16_t*)(p.ws + OFF_YGLA)
                   : (n == 1 ? (const bf16_t*)(p.ws + OFF_YHG) : (const bf16_t*)(p.ws + OFF_R + R_O));
      B = (const bf16_t*)(p.ws + OFF_WBRT) + (size_t)n * 1024 * 1024;
    }
    f32x16 acc[2][2];
    zero_acc22(acc);
    gemm_mainloop(acc, A, 1024, B, 1024, 1024, m0, n0, smem);
    int zz = 0;
    asm volatile("" : "+v"(zz));
    float4* const park = park0 + zz;
    if (kind == 0) {
#pragma unroll
      for (int mt = 0; mt < 2; ++mt)
#pragma unroll
        for (int nt = 0; nt < 2; ++nt)
#pragma unroll
          for (int q2 = 0; q2 < 2; ++q2) {
            uint4 gq;
            gq.x = pack2(sigmoidf_(acc[mt][nt][8 * q2 + 0]), sigmoidf_(acc[mt][nt][8 * q2 + 1]));
            gq.y = pack2(sigmoidf_(acc[mt][nt][8 * q2 + 2]), sigmoidf_(acc[mt][nt][8 * q2 + 3]));
            gq.z = pack2(sigmoidf_(acc[mt][nt][8 * q2 + 4]), sigmoidf_(acc[mt][nt][8 * q2 + 5]));
            gq.w = pack2(sigmoidf_(acc[mt][nt][8 * q2 + 6]), sigmoidf_(acc[mt][nt][8 * q2 + 7]));
            *(uint4*)(park + (16 + (mt * 2 + nt) * 2 + q2) * 256) = gq;
            asm volatile("" ::: "memory");
          }
    } else {
#pragma unroll
      for (int mt = 0; mt < 2; ++mt)
#pragma unroll
        for (int nt = 0; nt < 2; ++nt)
#pragma unroll
          for (int q2 = 0; q2 < 2; ++q2) {
            const uint4 gq = *(const uint4*)(park + (16 + (mt * 2 + nt) * 2 + q2) * 256);
            const unsigned gu[4] = {gq.x, gq.y, gq.z, gq.w};
#pragma unroll
            for (int qq = 0; qq < 2; ++qq) {
              const int q = 2 * q2 + qq;
              float4 t;
              t.x = bflo(gu[2 * qq]) * acc[mt][nt][4 * q];
              t.y = bfhi(gu[2 * qq]) * acc[mt][nt][4 * q + 1];
              t.z = bflo(gu[2 * qq + 1]) * acc[mt][nt][4 * q + 2];
              t.w = bfhi(gu[2 * qq + 1]) * acc[mt][nt][4 * q + 3];
              float4* pk = park + ((mt * 2 + nt) * 4 + q) * 256;
              if (n > 0) { float4 o = *pk; t.x += o.x; t.y += o.y; t.z += o.z; t.w += o.w; }
              if (n < 2) *pk = t;
              else {
                bf16_t* M = (bf16_t*)(p.ws + OFF_R) + zz + (size_t)(m0 + 64 * wm + 32 * mt + 8 * q + 4 * h) * 1024 + n0 + 64 * wn + 32 * nt + l32;
                M[0] = f2bf(t.x); M[1024] = f2bf(t.y); M[2048] = f2bf(t.z); M[3072] = f2bf(t.w);
              }
            }
            asm volatile("" ::: "memory");
          }
    }
  }
}

DI void merge_tile_big(const Params& p, int mtile, int ntile, char* smem) {
  const int m0 = mtile * 256, n0 = ntile * 256;
  const int tid = tid512_(), lane = tid & 63, w = tid >> 6, wm = w >> 2, wn = w & 3, l32 = lane & 31, h = lane >> 5;
  float4* const park0 = (float4*)(p.ws + OFF_R + SZ_ACT) + (size_t)blockIdx.x * (48 * 512) + tid;
#pragma unroll 1
  for (int pass = 0; pass < 6; ++pass) {
    const int n = pass >> 1, kind = pass & 1;
    const bf16_t* A;
    const bf16_t* B;
    if (kind == 0) {
      A = (const bf16_t*)(p.ws + OFF_H);
      B = (const bf16_t*)(p.ws + OFF_WINT) + (size_t)(11776 + n * 1024) * 1024;
    } else {
      A = (n == 0) ? (const bf16_t*)(p.ws + OFF_YGLA)
                   : (n == 1 ? (const bf16_t*)(p.ws + OFF_YHG) : (const bf16_t*)(p.ws + OFF_R + R_O));
      B = (const bf16_t*)(p.ws + OFF_WBRT) + (size_t)n * 1024 * 1024;
    }
    f32x16 acc[4][2];
    zero_acc<2>(acc);
    gemm512<2>(acc, A, B, m0, n0, smem);
    int zz = 0;
    asm volatile("" : "+v"(zz));
    float4* const park = park0 + zz;
    if (kind == 0) {
#pragma unroll
      for (int mt = 0; mt < 4; ++mt)
#pragma unroll
        for (int nt = 0; nt < 2; ++nt)
#pragma unroll
          for (int q2 = 0; q2 < 2; ++q2) {
            uint4 gq;
            gq.x = pack2(sigmoidf_(acc[mt][nt][8 * q2 + 0]), sigmoidf_(acc[mt][nt][8 * q2 + 1]));
            gq.y = pack2(sigmoidf_(acc[mt][nt][8 * q2 + 2]), sigmoidf_(acc[mt][nt][8 * q2 + 3]));
            gq.z = pack2(sigmoidf_(acc[mt][nt][8 * q2 + 4]), sigmoidf_(acc[mt][nt][8 * q2 + 5]));
            gq.w = pack2(sigmoidf_(acc[mt][nt][8 * q2 + 6]), sigmoidf_(acc[mt][nt][8 * q2 + 7]));
            *(uint4*)(park + (32 + (mt * 2 + nt) * 2 + q2) * 512) = gq;
            asm volatile("" ::: "memory");
          }
    } else {
#pragma unroll
      for (int mt = 0; mt < 4; ++mt)
#pragma unroll
        for (int nt = 0; nt < 2; ++nt)
#pragma unroll
          for (int q2 = 0; q2 < 2; ++q2) {
            const uint4 gq = *(const uint4*)(park + (32 + (mt * 2 + nt) * 2 + q2) * 512);
            const unsigned gu[4] = {gq.x, gq.y, gq.z, gq.w};
#pragma unroll
            for (int qq = 0; qq < 2; ++qq) {
              const int q = 2 * q2 + qq;
              float4 t;
              t.x = bflo(gu[2 * qq]) * acc[mt][nt][4 * q];
              t.y = bfhi(gu[2 * qq]) * acc[mt][nt][4 * q + 1];
              t.z = bflo(gu[2 * qq + 1]) * acc[mt][nt][4 * q + 2];
              t.w = bfhi(gu[2 * qq + 1]) * acc[mt][nt][4 * q + 3];
              float4* pk = park + ((mt * 2 + nt) * 4 + q) * 512;
              if (n > 0) { float4 o = *pk; t.x += o.x; t.y += o.y; t.z += o.z; t.w += o.w; }
              if (n < 2) *pk = t;
              else {
                bf16_t* M = (bf16_t*)(p.ws + OFF_R) + (size_t)(m0 + zz + 128 * wm + 32 * mt + 8 * q + 4 * h) * 1024 + n0 + 64 * wn + 32 * nt + l32;
                M[0] = f2bf(t.x); M[1024] = f2bf(t.y); M[2048] = f2bf(t.z); M[3072] = f2bf(t.w);
              }
            }
            asm volatile("" ::: "memory");
          }
    }
  }
}

DI void outproj_tile(const Params& p, int l, int mtile, int ntile, char* smem) {
  const int m0 = mtile * 128, n0 = ntile * 128;
  f32x16 acc[2][2];
  zero_acc22(acc);
  gemm_mainloop(acc, (const bf16_t*)(p.ws + OFF_R), 1024, (const bf16_t*)(p.ws + OFF_WOUTT), 1024, 1024, m0, n0, smem);
  const int tid = tid_(), lane = tid & 63, w = tid >> 6, wm = w >> 1, wn = w & 1, l32 = lane & 31, h = lane >> 5;
  const int b = m0 / SP, pos0 = m0 % SP;
  const bool isctx = pos0 < 256;
  const float* gate = (const float*)(p.ws + OFF_MOD) + ((size_t)(l * 9 + (isctx ? 8 : b))) * 3072 + 2048;
  const float* src;
  float* dst;
  if (isctx) {
    src = p.ctx + (size_t)(b * 256 + pos0) * 1024;
    dst = (float*)(p.ws + OFF_CTX1) + (size_t)(b * 256 + pos0) * 1024;
  } else {
    src = (l == 0 ? p.x : (const float*)p.out) + (size_t)(b * 4096 + pos0 - 256) * 1024;
    dst = p.out + (size_t)(b * 4096 + pos0 - 256) * 1024;
  }
#pragma unroll
  for (int nt = 0; nt < 2; ++nt) {
    const int col = n0 + 64 * wn + 32 * nt + l32;
    const float gt = gate[col];
#pragma unroll
    for (int mt = 0; mt < 2; ++mt)
#pragma unroll
      for (int i = 0; i < 16; ++i) {
        const size_t off = (size_t)(64 * wm + 32 * mt + 8 * (i >> 2) + 4 * h + (i & 3)) * 1024 + col;
        dst[off] = src[off] + gt * acc[mt][nt][i];
      }
  }
}

DI void final_rows(const Params& p, int row0, int nrows) {
  const int tid = tid_(), lane = tid & 63, w = tid >> 6;
  for (int rr = w; rr < nrows; rr += 4) {
    float* rp = p.out + (size_t)(row0 + rr) * 1024;
    float4 v[4];
    float ss = 0.f;
#pragma unroll
    for (int i = 0; i < 4; ++i) {
      v[i] = *(const float4*)(rp + i * 256 + lane * 4);
      ss += v[i].x * v[i].x + v[i].y * v[i].y + v[i].z * v[i].z + v[i].w * v[i].w;
    }
#pragma unroll
    for (int o = 32; o >= 1; o >>= 1) ss += __shfl_xor(ss, o);
    const float rstd = rsqrtf(ss * (1.f / 1024.f) + EPSN);
#pragma unroll
    for (int i = 0; i < 4; ++i) {
      float4 g4 = *(const float4*)(p.final_g + i * 256 + lane * 4);
      float4 o4 = make_float4(v[i].x * rstd * g4.x, v[i].y * rstd * g4.y, v[i].z * rstd * g4.z, v[i].w * rstd * g4.w);
      *(float4*)(rp + i * 256 + lane * 4) = o4;
    }
  }
}

#define XB_TMO      128
#define XB_XCNT(j)  (256  + 64 * (j))
#define XB_XSUB(j)  (1280 + 64 * (j))
#define XB_XGEN(j)  (2304 + 64 * (j))
#define XB_TOP      3328
#define XB_TOPGEN   3392
#define XCD_BAR_WORDS 3456
#define XB_SPIN_CAP (1u << 22)
#define LAS __attribute__((address_space(3)))
DI unsigned xb_ld(unsigned* p) { return __hip_atomic_load(p, __ATOMIC_RELAXED, __HIP_MEMORY_SCOPE_AGENT); }
DI unsigned xb_add(unsigned* p, unsigned v) { return __hip_atomic_fetch_add(p, v, __ATOMIC_RELAXED, __HIP_MEMORY_SCOPE_AGENT); }
DI unsigned xb_xcc_id() { return (unsigned)__builtin_amdgcn_s_getreg((3 << 11) | 20) & 0xFu; }
#define XB_SPIN(cond, bar) do { unsigned _sp = 0; while (cond) { __builtin_amdgcn_s_sleep(1); \
    if ((++_sp & 255u) == 0u) { if (xb_ld(&(bar)[XB_TMO])) break; if (_sp > XB_SPIN_CAP) { atomicAdd(&(bar)[XB_TMO], 1u); break; } } } } while (0)
struct XcdBarrier { unsigned* bar; unsigned x; volatile LAS unsigned* st; };
DI XcdBarrier xcd_barrier_post(unsigned* bar, volatile LAS unsigned* st) {
  XcdBarrier b; b.bar = bar; b.x = xb_xcc_id(); b.st = st;
  if (threadIdx.x == 0) (void)xb_add(&bar[XB_XCNT(b.x)], 1u);
  return b;
}
DI void xcd_barrier_complete(unsigned* bar, unsigned x, unsigned& nloc, unsigned& nx) {
  const unsigned G = gridDim.x * gridDim.y * gridDim.z;
  unsigned sum, cnt, mine, sp = 0u;
  for (;;) {
    sum = 0u; cnt = 0u; mine = 0u;
#pragma unroll
    for (unsigned j = 0; j < 16; ++j) { const unsigned c = xb_ld(&bar[XB_XCNT(j)]); sum += c; cnt += (c > 0u) ? 1u : 0u; mine = (j == x) ? c : mine; }
    if (sum == G) break;
    __builtin_amdgcn_s_sleep(1);
    if ((++sp & 255u) == 0u) { if (xb_ld(&bar[XB_TMO])) break; if (sp > XB_SPIN_CAP) { atomicAdd(&bar[XB_TMO], 1u); break; } }
  }
  nloc = mine > 0u ? mine : 1u; nx = cnt > 0u ? cnt : 1u;
}
DI void xcd_barrier(const XcdBarrier& b) {
  asm volatile("s_waitcnt vmcnt(0)" ::: "memory");
  __syncthreads();
  if (threadIdx.x == 0) {
    size_t zb = 0;
    asm volatile("" : "+s"(zb));
    unsigned* bar = b.bar + zb;
    unsigned bx = b.x;
    asm volatile("" : "+s"(bx));
    __builtin_amdgcn_s_waitcnt(0);
    unsigned nloc = b.st[0], nx = b.st[1];
    if (nloc == 0u) { xcd_barrier_complete(bar, bx, nloc, nx); b.st[0] = nloc; b.st[1] = nx; }
    const unsigned old = xb_add(&bar[XB_XSUB(bx)], 1u);
    const unsigned gen = old / nloc;
    if (old + 1u == (gen + 1u) * nloc) {
      __builtin_amdgcn_fence(__ATOMIC_RELEASE, "agent");
      asm volatile("s_waitcnt vmcnt(0)" ::: "memory");
      const unsigned og = xb_add(&bar[XB_TOP], 1u);
      const unsigned tg = og / nx;
      if (og + 1u == (tg + 1u) * nx) xb_add(&bar[XB_TOPGEN], 1u);
      else XB_SPIN(xb_ld(&bar[XB_TOPGEN]) == tg, bar);
      __builtin_amdgcn_fence(__ATOMIC_ACQUIRE, "agent");
      xb_add(&bar[XB_XGEN(bx)], 1u);
      asm volatile("s_waitcnt vmcnt(0)" ::: "memory");
    } else {
      XB_SPIN(xb_ld(&bar[XB_XGEN(bx)]) == gen, bar);
      __builtin_amdgcn_fence(__ATOMIC_ACQUIRE, "agent");
      asm volatile("s_waitcnt vmcnt(0)" ::: "memory");
    }
  }
  __syncthreads();
}

DI Params launder(Params p) {
  size_t z = 0;
  asm volatile("" : "+s"(z));
  p.ws += z;
  p.out += z;
  p.x += z;
  p.w_in += z;
  return p;
}

__global__ void __launch_bounds__(512) fwd_megakernel(Params p) {
  cg::grid_group grid = cg::this_grid();
  __shared__ __attribute__((aligned(16))) char smem_all[147456];
  const int half = __builtin_amdgcn_readfirstlane((int)(threadIdx.x >> 8));
  char* smem = smem_all + half * 73728;
  const int rnb = gridDim.x, rbid = blockIdx.x;
  const int nb = 2 * rnb, bid = 2 * rbid + half;
  __shared__ uint4 xb_words;
  if (threadIdx.x == 0) xb_words = make_uint4(0u, 0u, 0u, 0u);
  __syncthreads();
  const XcdBarrier xb = xcd_barrier_post((unsigned*)(p.ws + OFF_BAR), (volatile LAS unsigned*)&xb_words);

  for (int it = bid; it < 192 + NW_ITEMS + 2; it += nb) {
    if (it < 192) modp_item(p, it, smem);
    else if (it < 192 + NW_ITEMS) weight_item(p, 0, it - 192, smem);
    else if (it == 192 + NW_ITEMS) tables_item(p);
  }
  grid.sync();
  {
    float* mod = (float*)(p.ws + OFF_MOD);
    const float* mp = (const float*)(p.ws + OFF_MODP);
    for (int e = rbid * 512 + threadIdx.x; e < 2 * 9 * 3072; e += rnb * 512) {
      const int l = e / (9 * 3072), rj = e % (9 * 3072), j = rj % 3072;
      float s = p.b_ada[l * 3072 + j];
#pragma unroll
      for (int kp = 0; kp < 8; ++kp) s += mp[(size_t)(kp * 2 + l) * 9 * 3072 + rj];
      mod[e] = s;
    }
  }
  xcd_barrier(xb);

  for (int l = 0; l < 2; ++l) {
    {
      const Params q = launder(p);
      const int nwi = (l == 1) ? NW_ITEMS : 0;
      for (int it = bid; it < 272 + nwi; it += nb) {
        if (it < 272) h_item(q, l, it);
        else weight_item(q, 1, it - 272, smem);
      }
    }
    xcd_barrier(xb);
    for (int u = 0; u < 5; ++u) {
      {
        const Params q = launder(p);
        const int ntn = (u < 2) ? 8 : 10;
        const int nh = ntn >> 1, g = rbid & 1, mq = (rbid >> 1) & 3, xw = rnb >> 3;
        for (int t = rbid >> 3; t < 32 * nh; t += xw) inproj_tile(q, l, u, mq * 32 + t / nh, g * nh + t % nh, smem_all);
        const int nts = 2 * ntn;
        for (int it = bid; it < 16 * nts; it += nb) inproj_tile_small(q, l, u, 256 + it / nts, it % nts, smem);
      }
      xcd_barrier(xb);
      if (u < 4) {
        {
          const Params q = launder(p);
          for (int it = rbid; it < 128; it += rnb) scan_item(q, u, it, smem_all);
        }
        xcd_barrier(xb);
        {
          const Params q = launder(p);
          for (int it = bid; it < T / 16; it += nb) norm_rows(q, l, u, it * 16, 16);
        }
        xcd_barrier(xb);
      } else {
        const Params q = launder(p);
        const int nit = (l == 0) ? 2048 + 128 : 2048;
        for (int it = bid; it < nit; it += nb) attn_item(q, l, it, smem);
        xcd_barrier(xb);
      }
    }
    {
      const Params q = launder(p);
      for (int t = rbid; t < 512; t += rnb) {
        const int k = t >> 2;
        const int mt = (l == 1) ? (k >> 4) * 17 + 1 + (k & 15) : k;
        merge_tile_big(q, mt, t & 3, smem_all);
      }
    }
    xcd_barrier(xb);
    if (l == 0) {
      {
        const Params q = launder(p);
        for (int it = bid; it < 128 + 2048; it += nb) {
          if (it < 128) merge_tile(q, 256 + (it >> 3), it & 7, smem);
          else outproj_tile(q, l, (it - 128) >> 3, (it - 128) & 7, smem);
        }
      }
      xcd_barrier(xb);
      {
        const Params q = launder(p);
        for (int it = bid; it < 128; it += nb) outproj_tile(q, l, 256 + (it >> 3), it & 7, smem);
      }
    } else {
      const Params q = launder(p);
      const int xw = nb >> 3, ng = bid & 3, mh = (bid >> 2) & 1;
      for (int j = bid >> 3; j < 272; j += xw) {
        const int mt = mh * 136 + (j >> 1), nt = ng * 2 + (j & 1);
        if ((mt % 34) < 2) continue;
        outproj_tile(q, l, mt, nt, smem);
      }
    }
    xcd_barrier(xb);
  }
  {
    const Params q = launder(p);
    for (int it = bid; it < 32768 / 16; it += nb) final_rows(q, it * 16, 16);
  }
}

extern "C" void kernel_launch(void* const* d_in, const int* in_sizes, int n_in, void* d_out, int out_size, void* d_ws,
                              size_t ws_size, hipStream_t stream) {
  static int grid_blocks = 0;
  if (!grid_blocks) {
    int dev = 0, cus = 0, per_cu = 0;
    hipGetDevice(&dev);
    hipDeviceGetAttribute(&cus, hipDeviceAttributeMultiprocessorCount, dev);
    hipOccupancyMaxActiveBlocksPerMultiprocessor(&per_cu, fwd_megakernel, 512, 0);
    if (per_cu < 1) per_cu = 1;
    if (per_cu > 1) per_cu = 1;
    grid_blocks = cus * per_cu;
  }
  if (ws_size < WS_NEED) fprintf(stderr, "workspace too small: %zu < %zu\n", ws_size, (size_t)WS_NEED);
  Params p{};
  p.x = (const float*)d_in[0]; p.c = (const float*)d_in[1]; p.ctx = (const float*)d_in[2]; p.c_ctx = (const float*)d_in[3];
  p.norm_g = (const float*)d_in[4]; p.w_ada = (const float*)d_in[5]; p.b_ada = (const float*)d_in[6];
  p.w_in = (const float*)d_in[7]; p.gla_w_a2 = (const float*)d_in[8]; p.gla_b_a2 = (const float*)d_in[9];
  p.gla_norm_g = (const float*)d_in[10]; p.hgrn_lb = (const float*)d_in[11]; p.hgrn_norm_g = (const float*)d_in[12];
  p.attn_sink = (const float*)d_in[13]; p.w_branch = (const float*)d_in[14]; p.w_out = (const float*)d_in[15];
  p.final_g = (const float*)d_in[16];
  p.out = (float*)d_out;
  p.ws = (char*)d_ws;
  (void)hipMemsetAsync((char*)d_ws + OFF_BAR, 0, XCD_BAR_WORDS * 4, stream);
  void* args[] = {&p};
  hipError_t e = hipLaunchCooperativeKernel((void*)fwd_megakernel, dim3(grid_blocks), dim3(512), args, 0, stream);
  if (e != hipSuccess) fprintf(stderr, "cooperative launch failed: %s (grid %d)\n", hipGetErrorString(e), grid_blocks);
}
```
